# Optimizing an MI355X kernel written in HIP

```python
import math
import jax, jax.numpy as jnp
from jax import lax
import numpy as np

D_MODEL = 1024
BATCH = 4
SEQ = 4096
DEPTH = 1
DEC_BATCH = 128
DEC_SEQ = 1
PAST_LEN = 8192
PAGE_SIZE = 128

N_Q_HEADS = 8
N_KV_HEADS = 2
HEAD_DIM = 64
Q_PER_KV = N_Q_HEADS // N_KV_HEADS
ATTN_WIDTH = N_Q_HEADS * HEAD_DIM
KV_WIDTH = N_KV_HEADS * HEAD_DIM
WINDOW = 128
ROPE_DIM = HEAD_DIM // 4
ROPE_THETA = 500000.0
SSM_WIDTH = D_MODEL // 2
SSM_GROUP = 16
N_SSM_GROUPS = SSM_WIDTH // SSM_GROUP
SSM_STATE = 64
GATE_WIDTH = 2 * D_MODEL
IN_WIDTH = ATTN_WIDTH + 2 * KV_WIDTH + SSM_WIDTH + GATE_WIDTH
D_FF = -(-8 * D_MODEL // (3 * 256)) * 256
NORM_EPS = 1e-5

kernel_name = "swa_sink_s5_gated_hybrid_step"


def rms_norm(x, g):
    xf = x.astype(jnp.float32)
    y = xf * lax.rsqrt(jnp.mean(xf * xf, axis=-1, keepdims=True) + NORM_EPS)
    return (y * g.astype(jnp.float32)).astype(x.dtype)


def rope_partial(x, pos):
    half = ROPE_DIM // 2
    inv_freq = ROPE_THETA ** (-(jnp.arange(half, dtype=jnp.float32) * 2.0 / ROPE_DIM))
    ang = pos.astype(jnp.float32)[:, None] * inv_freq[None, :]
    cos = jnp.cos(ang)[:, None, :]
    sin = jnp.sin(ang)[:, None, :]
    xr = x[..., :ROPE_DIM].astype(jnp.float32)
    x1, x2 = xr[..., :half], xr[..., half:]
    rot = jnp.concatenate([x1 * cos - x2 * sin, x2 * cos + x1 * sin], axis=-1)
    return jnp.concatenate([rot.astype(x.dtype), x[..., ROPE_DIM:]], axis=-1)


def sink_softmax(scores, mask, sinks):
    s = jnp.where(mask, scores, -jnp.inf)
    sk = jnp.broadcast_to(sinks.astype(jnp.float32)[:, :, None, None], s.shape[:-1] + (1,))
    p = jax.nn.softmax(jnp.concatenate([s, sk], axis=-1), axis=-1)
    return p[..., :-1]


def swa_prompt(q, k, v, sinks):
    B, T = q.shape[0], q.shape[1]
    nb = T // WINDOW
    qb = q.reshape(B, nb, WINDOW, N_KV_HEADS, Q_PER_KV, HEAD_DIM)
    kb = k.reshape(B, nb, WINDOW, N_KV_HEADS, HEAD_DIM)
    vb = v.reshape(B, nb, WINDOW, N_KV_HEADS, HEAD_DIM)
    kk = jnp.concatenate([jnp.concatenate([jnp.zeros_like(kb[:, :1]), kb[:, :-1]], axis=1), kb], axis=2)
    vv = jnp.concatenate([jnp.concatenate([jnp.zeros_like(vb[:, :1]), vb[:, :-1]], axis=1), vb], axis=2)
    scale = HEAD_DIM ** -0.5
    scores = jnp.einsum('bnqkgd,bnskd->bnkgqs', qb, kk, preferred_element_type=jnp.float32) * scale
    n = jnp.arange(nb)[:, None, None]
    i = jnp.arange(WINDOW)[None, :, None]
    j = jnp.arange(2 * WINDOW)[None, None, :]
    qpos = n * WINDOW + i
    kpos = (n - 1) * WINDOW + j
    mask = (kpos >= 0) & (kpos <= qpos) & (qpos - kpos < WINDOW)
    p = sink_softmax(scores, mask[None, :, None, None], sinks.reshape(N_KV_HEADS, Q_PER_KV))
    out = jnp.einsum('bnkgqs,bnskd->bnqkgd', p.astype(v.dtype), vv)
    wb = min(WINDOW, T)
    return out.reshape(B, T, ATTN_WIDTH), k[:, T - wb:], v[:, T - wb:]


def swa_sample(q, k, v, sinks, k_buf, v_buf):
    DB, S = q.shape[0], q.shape[1]
    wb = k_buf.shape[1]
    kk = jnp.concatenate([k_buf.astype(k.dtype), k], axis=1)
    vv = jnp.concatenate([v_buf.astype(v.dtype), v], axis=1)
    qg = q.reshape(DB, S, N_KV_HEADS, Q_PER_KV, HEAD_DIM)
    scale = HEAD_DIM ** -0.5
    scores = jnp.einsum('bqkgd,bskd->bkgqs', qg, kk, preferred_element_type=jnp.float32) * scale
    qpos = PAST_LEN + jnp.arange(S)[:, None]
    kpos = PAST_LEN - wb + jnp.arange(wb + S)[None, :]
    mask = (kpos <= qpos) & (qpos - kpos < WINDOW)
    p = sink_softmax(scores, mask, sinks.reshape(N_KV_HEADS, Q_PER_KV))
    out = jnp.einsum('bkgqs,bskd->bqkgd', p.astype(v.dtype), vv)
    return out.reshape(DB, S, ATTN_WIDTH), kk[:, S:], vv[:, S:]


def s5_discretize(lam_re, lam_im, log_dt, b_re, b_im):
    lam_re = lam_re.astype(jnp.float32)
    lam_im = lam_im.astype(jnp.float32)
    dt = jnp.exp(log_dt.astype(jnp.float32))[:, None]
    mag = jnp.exp(lam_re * dt)
    lb_re = mag * jnp.cos(lam_im * dt)
    lb_im = mag * jnp.sin(lam_im * dt)
    den = lam_re * lam_re + lam_im * lam_im
    nr = lb_re - 1.0
    c_re = ((nr * lam_re + lb_im * lam_im) / den)[..., None]
    c_im = ((lb_im * lam_re - nr * lam_im) / den)[..., None]
    b_re = b_re.astype(jnp.float32)
    b_im = b_im.astype(jnp.float32)
    bb_re = c_re * b_re - c_im * b_im
    bb_im = c_re * b_im + c_im * b_re
    return lb_re, lb_im, bb_re, bb_im


def _affine_combine(e1, e2):
    ar1, ai1, br1, bi1 = e1
    ar2, ai2, br2, bi2 = e2
    return (ar1 * ar2 - ai1 * ai2,
            ar1 * ai2 + ai1 * ar2,
            ar2 * br1 - ai2 * bi1 + br2,
            ar2 * bi1 + ai2 * br1 + bi2)


def s5_branch(u, h0_re, h0_im, lam_re, lam_im, log_dt, b_re, b_im, c_re, c_im, d, w_glu, b_glu):
    B, T = u.shape[0], u.shape[1]
    lb_re, lb_im, bb_re, bb_im = s5_discretize(lam_re, lam_im, log_dt, b_re, b_im)
    ug = u.reshape(B, T, N_SSM_GROUPS, SSM_GROUP).astype(jnp.float32)
    bu_re = jnp.einsum('gph,btgh->btgp', bb_re, ug)
    bu_im = jnp.einsum('gph,btgh->btgp', bb_im, ug)
    h0r = h0_re.astype(jnp.float32)
    h0i = h0_im.astype(jnp.float32)
    bu_re = bu_re.at[:, 0].add(lb_re * h0r - lb_im * h0i)
    bu_im = bu_im.at[:, 0].add(lb_re * h0i + lb_im * h0r)
    a_re = jnp.broadcast_to(lb_re, bu_re.shape)
    a_im = jnp.broadcast_to(lb_im, bu_im.shape)
    _, _, h_re, h_im = lax.associative_scan(_affine_combine, (a_re, a_im, bu_re, bu_im), axis=1)
    y = (jnp.einsum('ghp,btgp->btgh', c_re.astype(jnp.float32), h_re)
         - jnp.einsum('ghp,btgp->btgh', c_im.astype(jnp.float32), h_im))
    y = y.reshape(B, T, SSM_WIDTH) + d.astype(jnp.float32) * u.astype(jnp.float32)
    z = jax.nn.gelu(y).astype(u.dtype)
    out = z * jax.nn.sigmoid(z @ w_glu + b_glu)
    return out, h_re[:, -1].astype(u.dtype), h_im[:, -1].astype(u.dtype)


def hybrid_layer(x, pos, attend, h0_re, h0_im, norm1_g, w_in, b_gate, attn_sinks,
                 ssm_lam_re, ssm_lam_im, ssm_log_dt, ssm_b_re, ssm_b_im, ssm_c_re, ssm_c_im,
                 ssm_d, w_glu, b_glu, w_branch_attn, w_branch_ssm, w_out, norm2_g,
                 w_ffn_gate, w_ffn_up, w_ffn_down):
    B, T = x.shape[0], x.shape[1]
    h = rms_norm(x, norm1_g)
    proj = h @ w_in
    o1 = ATTN_WIDTH
    o2 = o1 + KV_WIDTH
    o3 = o2 + KV_WIDTH
    o4 = o3 + SSM_WIDTH
    q = rope_partial(proj[..., :o1].reshape(B, T, N_Q_HEADS, HEAD_DIM), pos)
    k = rope_partial(proj[..., o1:o2].reshape(B, T, N_KV_HEADS, HEAD_DIM), pos)
    v = proj[..., o2:o3].reshape(B, T, N_KV_HEADS, HEAD_DIM)
    u = proj[..., o3:o4]
    gates = proj[..., o4:] + b_gate
    attn_out, k_state, v_state = attend(q, k, v, attn_sinks)
    ssm_out, hr, hi = s5_branch(u, h0_re, h0_im, ssm_lam_re, ssm_lam_im, ssm_log_dt, ssm_b_re,
                                ssm_b_im, ssm_c_re, ssm_c_im, ssm_d, w_glu, b_glu)
    merged = (jax.nn.sigmoid(gates[..., :D_MODEL]) * (attn_out @ w_branch_attn)
              + jax.nn.sigmoid(gates[..., D_MODEL:]) * (ssm_out @ w_branch_ssm))
    x = x + merged @ w_out
    h2 = rms_norm(x, norm2_g)
    x = x + (jax.nn.silu(h2 @ w_ffn_gate) * (h2 @ w_ffn_up)) @ w_ffn_down
    return x, k_state, v_state, hr, hi


def setup_inputs(seed: int = 0) -> dict:
    key = jax.random.key(seed)
    ks = jax.random.split(key, 32)
    f32 = jnp.float32

    def nrm(k, shape, scale):
        return jax.random.normal(k, shape, f32) * scale

    wb = min(WINDOW, PAST_LEN)
    G, P, H = N_SSM_GROUPS, SSM_STATE, SSM_GROUP
    lam_im0 = math.pi * jnp.arange(P, dtype=f32)
    return {
        "x_prompt": nrm(ks[0], (BATCH, SEQ, D_MODEL), 1.0),
        "x_sample": nrm(ks[1], (DEC_BATCH, DEC_SEQ, D_MODEL), 1.0),
        "state_k_win": nrm(ks[2], (DEPTH, DEC_BATCH, wb, N_KV_HEADS, HEAD_DIM), 1.0),
        "state_v_win": nrm(ks[3], (DEPTH, DEC_BATCH, wb, N_KV_HEADS, HEAD_DIM), 1.0),
        "state_ssm_re": nrm(ks[4], (DEPTH, DEC_BATCH, G, P), 0.3),
        "state_ssm_im": nrm(ks[5], (DEPTH, DEC_BATCH, G, P), 0.3),
        "norm1_g": 1.0 + nrm(ks[6], (DEPTH, D_MODEL), 0.02),
        "w_in": nrm(ks[7], (DEPTH, D_MODEL, IN_WIDTH), D_MODEL ** -0.5),
        "b_gate": nrm(ks[8], (DEPTH, GATE_WIDTH), 0.02),
        "attn_sinks": nrm(ks[9], (DEPTH, N_Q_HEADS), 1.0),
        "ssm_lam_re": -0.5 + nrm(ks[10], (DEPTH, G, P), 0.01),
        "ssm_lam_im": lam_im0 + nrm(ks[11], (DEPTH, G, P), 0.01),
        "ssm_log_dt": jax.random.uniform(ks[12], (DEPTH, G), f32, math.log(1e-3), math.log(1e-1)),
        "ssm_b_re": nrm(ks[13], (DEPTH, G, P, H), (2 * H) ** -0.5),
        "ssm_b_im": nrm(ks[14], (DEPTH, G, P, H), (2 * H) ** -0.5),
        "ssm_c_re": nrm(ks[15], (DEPTH, G, H, P), P ** -0.5),
        "ssm_c_im": nrm(ks[16], (DEPTH, G, H, P), P ** -0.5),
        "ssm_d": nrm(ks[17], (DEPTH, SSM_WIDTH), 1.0),
        "w_glu": nrm(ks[18], (DEPTH, SSM_WIDTH, SSM_WIDTH), SSM_WIDTH ** -0.5),
        "b_glu": nrm(ks[19], (DEPTH, SSM_WIDTH), 0.02),
        "w_branch_attn": nrm(ks[20], (DEPTH, ATTN_WIDTH, D_MODEL), ATTN_WIDTH ** -0.5),
        "w_branch_ssm": nrm(ks[21], (DEPTH, SSM_WIDTH, D_MODEL), SSM_WIDTH ** -0.5),
        "w_out": nrm(ks[22], (DEPTH, D_MODEL, D_MODEL), D_MODEL ** -0.5),
        "norm2_g": 1.0 + nrm(ks[23], (DEPTH, D_MODEL), 0.02),
        "w_ffn_gate": nrm(ks[24], (DEPTH, D_MODEL, D_FF), D_MODEL ** -0.5),
        "w_ffn_up": nrm(ks[25], (DEPTH, D_MODEL, D_FF), D_MODEL ** -0.5),
        "w_ffn_down": nrm(ks[26], (DEPTH, D_FF, D_MODEL), D_FF ** -0.5),
        "norm_f_g": 1.0 + nrm(ks[27], (D_MODEL,), 0.02),
    }


def reference(x_prompt, x_sample, state_k_win, state_v_win, state_ssm_re, state_ssm_im,
              norm1_g, w_in, b_gate, attn_sinks, ssm_lam_re, ssm_lam_im, ssm_log_dt,
              ssm_b_re, ssm_b_im, ssm_c_re, ssm_c_im, ssm_d, w_glu, b_glu,
              w_branch_attn, w_branch_ssm, w_out, norm2_g, w_ffn_gate, w_ffn_up, w_ffn_down,
              norm_f_g):
    pos_p = jnp.arange(x_prompt.shape[1], dtype=jnp.int32)
    pos_s = PAST_LEN + jnp.arange(x_sample.shape[1], dtype=jnp.int32)
    zeros_h = jnp.zeros((x_prompt.shape[0], N_SSM_GROUPS, SSM_STATE), x_prompt.dtype)
    xp, xs = x_prompt, x_sample
    kp_l, vp_l, hrp_l, hip_l = [], [], [], []
    ks_l, vs_l, hrs_l, his_l = [], [], [], []
    for l in range(DEPTH):
        weights = (norm1_g[l], w_in[l], b_gate[l], attn_sinks[l], ssm_lam_re[l], ssm_lam_im[l],
                   ssm_log_dt[l], ssm_b_re[l], ssm_b_im[l], ssm_c_re[l], ssm_c_im[l], ssm_d[l],
                   w_glu[l], b_glu[l], w_branch_attn[l], w_branch_ssm[l], w_out[l], norm2_g[l],
                   w_ffn_gate[l], w_ffn_up[l], w_ffn_down[l])
        xp, kp, vp, hrp, hip = hybrid_layer(xp, pos_p, swa_prompt, zeros_h, zeros_h, *weights)
        kbuf, vbuf = state_k_win[l], state_v_win[l]
        attend_s = lambda q, k, v, s, kb=kbuf, vb=vbuf: swa_sample(q, k, v, s, kb, vb)
        xs, ksn, vsn, hrs, his = hybrid_layer(xs, pos_s, attend_s, state_ssm_re[l], state_ssm_im[l], *weights)
        kp_l.append(kp); vp_l.append(vp); hrp_l.append(hrp); hip_l.append(hip)
        ks_l.append(ksn); vs_l.append(vsn); hrs_l.append(hrs); his_l.append(his)
    y_prompt = rms_norm(xp, norm_f_g)
    y_sample = rms_norm(xs, norm_f_g)
    return (y_prompt, y_sample,
            jnp.stack(kp_l), jnp.stack(vp_l), jnp.stack(hrp_l), jnp.stack(hip_l),
            jnp.stack(ks_l), jnp.stack(vs_l), jnp.stack(hrs_l), jnp.stack(his_l))
```

```cpp
#include <hip/hip_runtime.h>
#include <hip/hip_cooperative_groups.h>
#include <cstdio>
#include <cstdint>
namespace cg = cooperative_groups;
namespace pg8 {
#define PG8_LAS __attribute__((address_space(3)))
typedef unsigned short bf16_t;
typedef short bf16x8 __attribute__((ext_vector_type(8)));
typedef float f32x4 __attribute__((ext_vector_type(4)));
typedef unsigned u32x4 __attribute__((ext_vector_type(4)));
constexpr int BM = 256, BK = 64, HALF = 128, HTB = HALF * BK * 2  , STAGE_BYTES = 8 * HTB, NXCD = 8, WGM = 8;

__host__ __device__ __forceinline__ int lds_byte(int r, int c) { const int st = (r >> 4) * 2 + (c >> 5), rr = r & 15, cc = c & 31, ob = rr * 64 + cc * 2; return st * 1024 + (ob ^ (((ob >> 9) & 1) << 5)); }
__host__ __device__ __forceinline__ void stage_rc(int b, int& R, int& C) { const int st = b / 1024, sb = b % 1024, swz = sb ^ (((sb >> 9) & 1) << 5); R = (st >> 1) * 16 + swz / 64; C = (st & 1) * 32 + (swz % 64) / 2; }
__host__ __device__ __forceinline__ int perm32(int rho) { const int n = rho >> 4, i = rho & 15; return 8 * (i >> 2) + 4 * n + (i & 3); }

struct Unit { int pm, pn; };
struct Gemm { const bf16_t* A; const bf16_t* Bt; int M, N, K; };

struct StaticOrder {
    int nM, nN, nwg, G, c;
    __host__ __device__ void init(int M, int N, int G_, int c_) { nM = M / BM; nN = N / BM; nwg = nM * nN; G = G_; c = c_; }
    __host__ __device__ bool next(int i, Unit& u) const {
        const long L = (long)i * G + c; if (L >= nwg) return false;
        int wgid = (int)L; { const int q = nwg / NXCD, r = nwg % NXCD, xcd = wgid % NXCD, off = wgid / NXCD; wgid = (xcd < r ? xcd * (q + 1) : r * (q + 1) + (xcd - r) * q) + off; }
        const int nig = WGM * nN, gid = wgid / nig, fm = gid * WGM, gsz = (nM - fm) < WGM ? (nM - fm) : WGM;
        u.pm = fm + ((wgid % nig) % gsz); u.pn = (wgid % nig) / gsz; return true;
    }
    __device__ __forceinline__ void a_ready(const Unit&) const {}
    __device__ __forceinline__ void done(const Unit&) const {}
};
template <class Epi, class Sched, bool ALIGN_EPI = false, bool SP2 = false>
__device__ __forceinline__ void gemm_phase(PG8_LAS unsigned char* lds, const Gemm g, const Sched& S, const Epi& E, const int wid, int tid) {
    asm volatile("" : "+v"(tid));
    const int lane = tid & 63, wr = wid >> 2, wc = wid & 3, fr = lane & 15, fq = lane >> 4;
    const int K = g.K, nt = K / BK;
    unsigned voffA[2], voffB[2];
#pragma unroll
    for (int i = 0; i < 2; ++i) { int R, C; stage_rc(tid * 16 + i * 8192, R, C); const int Rb = Epi::PERM ? ((R & ~31) + perm32(R & 31)) : R;
        voffA[i] = (unsigned)(R * K + C) * 2u; voffB[i] = (unsigned)(Rb * K + C) * 2u; }
    const size_t kstep = (size_t)(BK * 2);
    const size_t hstep = (size_t)HALF * K * 2;
    const size_t tstep = 2 * hstep;
    const unsigned ldsw = (unsigned)wid * 1024u;
    const int aoff = lds_byte(wr * 64 + fr, fq * 8), boff = lds_byte(wc * 32 + fr, fq * 8);
#define PG8_SA(b, h) (((b) * 2 + (h)) * HTB)
#define PG8_SB(b, h) ((4 + (b) * 2 + (h)) * HTB)
#define PG8_STAGE(bufoff, gbase, voff) do { _Pragma("unroll") for (int _i = 0; _i < 2; ++_i) \
        __builtin_amdgcn_global_load_lds((const unsigned*)((const char*)(gbase) + (voff)[_i]), (PG8_LAS unsigned*)(lds + (bufoff) + ldsw + _i * 8192), 16, 0, 0); } while (0)
#define PG8_LDA(dst, b, h) do { _Pragma("unroll") for (int m = 0; m < 4; ++m) _Pragma("unroll") for (int k = 0; k < 2; ++k) dst[m][k] = *(const PG8_LAS bf16x8*)(lds + PG8_SA(b, h) + aoff + m * 2048 + k * 1024); } while (0)
#define PG8_LDB(dst, b, h) do { _Pragma("unroll") for (int n = 0; n < 2; ++n) _Pragma("unroll") for (int k = 0; k < 2; ++k) dst[n][k] = *(const PG8_LAS bf16x8*)(lds + PG8_SB(b, h) + boff + n * 2048 + k * 1024); } while (0)
#define PG8_MMA(ai, bj, At, Bt) do { __builtin_amdgcn_s_setprio(1); _Pragma("unroll") for (int m = 0; m < 4; ++m) _Pragma("unroll") for (int n = 0; n < 2; ++n) _Pragma("unroll") for (int k = 0; k < 2; ++k) \
        acc[ai][bj][m][n] = __builtin_amdgcn_mfma_f32_16x16x32_bf16(Bt[n][k], At[m][k], acc[ai][bj][m][n], 0, 0, 0); __builtin_amdgcn_s_setprio(0); } while (0)
#define PG8_WAIT_V(n) asm volatile("s_waitcnt vmcnt(" #n ")" ::: "memory")
#define PG8_WAIT_L(n) asm volatile("s_waitcnt lgkmcnt(" #n ")" ::: "memory")
#define PG8_BAR __builtin_amdgcn_s_barrier()
#define PG8_SCHED __builtin_amdgcn_sched_barrier(0)
    Unit cur, nxt; int ui = 0;
    if (!S.next(0, cur)) return;
    f32x4 acc[2][2][4][2];
#pragma unroll
    for (int a = 0; a < 2; ++a)
#pragma unroll
        for (int b = 0; b < 2; ++b)
#pragma unroll
            for (int m = 0; m < 4; ++m)
#pragma unroll
                for (int n = 0; n < 2; ++n) acc[a][b][m][n] = (f32x4){0.f, 0.f, 0.f, 0.f};
    bf16x8 At[4][2], B0[2][2], B1[2][2];
    const char* cA = (const char*)g.A + (size_t)cur.pm * tstep; const char* cB = (const char*)g.Bt + (size_t)cur.pn * tstep;
    S.a_ready(cur);
    if constexpr (SP2) {
        PG8_STAGE(PG8_SB(0, 0), cB, voffB); PG8_STAGE(PG8_SB(0, 1), cB + hstep, voffB); PG8_STAGE(PG8_SA(0, 0), cA, voffA); PG8_STAGE(PG8_SA(0, 1), cA + hstep, voffA);
        if (wr == 1) PG8_BAR;
        PG8_WAIT_V(2); PG8_BAR;
        PG8_STAGE(PG8_SB(1, 0), cB + kstep, voffB); PG8_STAGE(PG8_SA(1, 0), cA + kstep, voffA); PG8_STAGE(PG8_SB(1, 1), cB + hstep + kstep, voffB);
        PG8_WAIT_V(6); PG8_BAR;
    } else {
        PG8_STAGE(PG8_SB(0, 0), cB, voffB); PG8_STAGE(PG8_SA(0, 0), cA, voffA); PG8_STAGE(PG8_SB(0, 1), cB + hstep, voffB); PG8_STAGE(PG8_SA(0, 1), cA + hstep, voffA);
        if (wr == 1) PG8_BAR;
        PG8_WAIT_V(4); PG8_BAR;
        PG8_STAGE(PG8_SB(1, 0), cB + kstep, voffB); PG8_STAGE(PG8_SA(1, 0), cA + kstep, voffA); PG8_STAGE(PG8_SB(1, 1), cB + hstep + kstep, voffB);
        PG8_WAIT_V(6); PG8_BAR;
    }
    for (;;) {
        const bool has_next = S.next(ui + 1, nxt);
        const char* nA = has_next ? (const char*)g.A + (size_t)nxt.pm * tstep : cA; const char* nB = has_next ? (const char*)g.Bt + (size_t)nxt.pn * tstep : cB;
        for (int t = 0; t < nt; t += 2) {
            const bool last = (t == nt - 2);
            const char* a1 = cA + (size_t)(t + 1) * kstep;
            const char* a2 = last ? nA : cA + (size_t)(t + 2) * kstep; const char* b2 = last ? nB : cB + (size_t)(t + 2) * kstep;
            const char* a3 = a2 + kstep; const char* b3 = b2 + kstep;
            if (last && has_next) S.a_ready(nxt);
            if constexpr (Epi::HAS_MID) { if (t == (nt >> 1)) E.mid(acc, cur, wr, wc, fr, fq); }
            if constexpr (SP2) {
            PG8_LDB(B0, 0, 0); PG8_LDB(B1, 0, 1); PG8_SCHED; PG8_LDA(At, 0, 0); PG8_STAGE(PG8_SA(1, 1), a1 + hstep, voffA);
            PG8_WAIT_V(8); PG8_WAIT_L(0); PG8_BAR; PG8_MMA(0, 0, At, B0); PG8_MMA(0, 1, At, B1); PG8_BAR; PG8_SCHED;
            PG8_LDA(At, 0, 1); PG8_STAGE(PG8_SB(0, 0), b2, voffB); PG8_STAGE(PG8_SB(0, 1), b2 + hstep, voffB); PG8_STAGE(PG8_SA(0, 0), a2, voffA);
            PG8_WAIT_V(8); PG8_WAIT_L(0); PG8_BAR; PG8_MMA(1, 0, At, B0); PG8_MMA(1, 1, At, B1); PG8_BAR; PG8_SCHED;
            PG8_LDB(B0, 1, 0); PG8_LDB(B1, 1, 1); PG8_SCHED; PG8_LDA(At, 1, 0); PG8_STAGE(PG8_SA(0, 1), a2 + hstep, voffA);
            PG8_WAIT_V(8); PG8_WAIT_L(0); PG8_BAR; PG8_MMA(0, 0, At, B0); PG8_MMA(0, 1, At, B1); PG8_BAR; PG8_SCHED;
            PG8_LDA(At, 1, 1); PG8_STAGE(PG8_SB(1, 0), b3, voffB); PG8_STAGE(PG8_SB(1, 1), b3 + hstep, voffB); PG8_STAGE(PG8_SA(1, 0), a3, voffA);
            PG8_WAIT_V(8); PG8_WAIT_L(0); PG8_BAR; PG8_MMA(1, 0, At, B0); PG8_MMA(1, 1, At, B1); PG8_BAR; PG8_SCHED;
            } else {
            PG8_LDB(B0, 0, 0); PG8_SCHED; PG8_LDA(At, 0, 0); PG8_STAGE(PG8_SA(1, 1), a1 + hstep, voffA);
            PG8_WAIT_L(8); PG8_BAR; PG8_WAIT_L(0); PG8_MMA(0, 0, At, B0); PG8_BAR; PG8_SCHED;
            PG8_LDB(B1, 0, 1); PG8_STAGE(PG8_SB(0, 0), b2, voffB);
            PG8_BAR; PG8_WAIT_L(0); PG8_MMA(0, 1, At, B1); PG8_BAR;
            PG8_LDA(At, 0, 1); PG8_STAGE(PG8_SA(0, 0), a2, voffA);
            PG8_BAR; PG8_WAIT_L(0); PG8_MMA(1, 0, At, B0); PG8_BAR; PG8_SCHED;
            PG8_STAGE(PG8_SB(0, 1), b2 + hstep, voffB);
            PG8_WAIT_V(6); PG8_BAR; PG8_MMA(1, 1, At, B1); PG8_BAR;
            PG8_LDB(B0, 1, 0); PG8_SCHED; PG8_LDA(At, 1, 0); PG8_STAGE(PG8_SA(0, 1), a2 + hstep, voffA);
            PG8_WAIT_L(8); PG8_BAR; PG8_WAIT_L(0); PG8_MMA(0, 0, At, B0); PG8_BAR; PG8_SCHED;
            PG8_LDB(B1, 1, 1); PG8_STAGE(PG8_SB(1, 0), b3, voffB);
            PG8_BAR; PG8_WAIT_L(0); PG8_MMA(0, 1, At, B1); PG8_BAR;
            PG8_LDA(At, 1, 1); PG8_STAGE(PG8_SA(1, 0), a3, voffA);
            PG8_BAR; PG8_WAIT_L(0); PG8_MMA(1, 0, At, B0); PG8_BAR; PG8_SCHED;
            PG8_STAGE(PG8_SB(1, 1), b3 + hstep, voffB);
            PG8_WAIT_V(6); PG8_BAR; PG8_MMA(1, 1, At, B1); PG8_BAR;
            }
        }
        if constexpr (ALIGN_EPI) { if (wr == 0) PG8_BAR; }
        if constexpr (!Epi::AFTER_DRAIN) { E(acc, cur, wr, wc, fr, fq); S.done(cur); }
        if (!has_next) break;
#pragma unroll
        for (int a = 0; a < 2; ++a)
#pragma unroll
            for (int b = 0; b < 2; ++b)
#pragma unroll
                for (int m = 0; m < 4; ++m)
#pragma unroll
                    for (int n = 0; n < 2; ++n) acc[a][b][m][n] = (f32x4){0.f, 0.f, 0.f, 0.f};
        cur = nxt; cA = nA; cB = nB; ++ui;
        if constexpr (ALIGN_EPI) { if (wr == 1) PG8_BAR; }
    }
    PG8_WAIT_V(0);
    if constexpr (!ALIGN_EPI) { if (wr == 0) PG8_BAR; }
    PG8_BAR;
    if constexpr (Epi::AFTER_DRAIN) { E.fused(acc, cur, wr, wc, fr, fq, lds, wid, lane); S.done(cur); }
#undef PG8_SA
#undef PG8_SB
#undef PG8_STAGE
#undef PG8_LDA
#undef PG8_LDB
#undef PG8_MMA
#undef PG8_WAIT_V
#undef PG8_WAIT_L
#undef PG8_BAR
#undef PG8_SCHED
}
}

#define LAS __attribute__((address_space(3)))
typedef unsigned short bf16;
typedef float f32x4 __attribute__((ext_vector_type(4)));
typedef float f32x2 __attribute__((ext_vector_type(2)));
typedef short bf16x8 __attribute__((ext_vector_type(8)));
typedef short bf16x4 __attribute__((ext_vector_type(4)));
typedef unsigned u32x4 __attribute__((ext_vector_type(4)));
typedef unsigned u32x2 __attribute__((ext_vector_type(2)));

constexpr int D = 1024, TPR = 4096, MPROMPT = 16384, NSAMP = 128, MR = 16512, MP = 16640;
constexpr int INW = 3328, FF = 2816, NGU = 5632;
constexpr float EPS = 1e-5f;
constexpr int NSEG = 16;
constexpr int NWAVES = 8, NTHREADS = 512;
constexpr int LDS_BYTES = 135168;

constexpr size_t O_Y = 0, O_KWP = 16908288, O_VWP = 16973824, O_SRP = 17039360, O_SIP = 17047552,
                 O_KWS = 17055744, O_VWS = 19152896, O_SRS = 21250048, O_SIS = 21512192;

constexpr size_t MiB = 1u << 20;
constexpr size_t WS_BAR = 96 * 1024, WS_CNT = 112 * 1024, WS_ZERO_BYTES = 256 * 1024;
constexpr size_t WS_SS1 = 0, WS_SS2 = 128 * 1024, WS_ROPE = 256 * 1024, WS_LBAR = 640 * 1024, WS_LBARS = 656 * 1024,
                 WS_BBM = 672 * 1024, WS_CCM = 800 * 1024, WS_BBF = 1024 * 1024;
constexpr size_t WS_WIN = 2 * MiB, WS_WGLU = 17 * MiB / 2, WS_WBA = 9 * MiB, WS_WBS = 10 * MiB, WS_WOUT = 11 * MiB, WS_WGU = 13 * MiB, WS_WD = 24 * MiB;
constexpr size_t WS_XB = 30 * MiB;
constexpr size_t WS_Q = 63 * MiB;
constexpr size_t WS_K = 80 * MiB, WS_V = 85 * MiB;
constexpr size_t WS_U = 90 * MiB;
constexpr size_t WS_G = 107 * MiB;
constexpr size_t WS_Z = 172 * MiB;
constexpr size_t WS_M = 189 * MiB;
constexpr size_t WS_E = 222 * MiB;
constexpr size_t WS_ACT = 63 * MiB;
constexpr size_t WS_AS = 223 * MiB;
constexpr size_t WS_END = 256 * MiB;
static_assert(WS_AS + (size_t)MP * D * 2 <= WS_END, "AS map");
static_assert(WS_ACT + (size_t)MP * FF * 2 <= WS_Z, "act overlay");
static_assert(WS_WIN + (size_t)INW * D * 2 <= WS_WGLU && WS_WGU + (size_t)NGU * D * 2 <= WS_WD && WS_WD + (size_t)D * FF * 2 <= WS_XB, "weights map");
static_assert(WS_XB + (size_t)MP * D * 2 <= WS_Q && WS_Q + (size_t)MP * 512 * 2 <= WS_K && WS_G + (size_t)MP * 2048 * 2 <= WS_Z && WS_M + (size_t)MP * D * 2 <= WS_E, "act map");

struct Params { const float* in[28]; float* out; unsigned char* ws; };

enum { I_XP = 0, I_XS, I_SK, I_SV, I_SRE, I_SIM, I_N1G, I_WIN, I_BG, I_SINK, I_LRE, I_LIM, I_LDT, I_BRE, I_BIM, I_CRE, I_CIM, I_SD, I_WGLU, I_BGLU,
       I_WBA, I_WBS, I_WOUT, I_N2G, I_WFG, I_WFU, I_WFD, I_NFG };

#define LDS_WAIT() asm volatile("s_waitcnt lgkmcnt(0)" ::: "memory")
__device__ __forceinline__ unsigned f2bf(float f) { unsigned u = __builtin_bit_cast(unsigned, f); return (u + 0x7fffu + ((u >> 16) & 1u)) >> 16; }
__device__ __forceinline__ unsigned pk2(float lo, float hi) { unsigned r; asm("v_cvt_pk_bf16_f32 %0, %1, %2" : "=v"(r) : "v"(lo), "v"(hi)); return r; }
__device__ __forceinline__ float bflo(unsigned w) { return __builtin_bit_cast(float, w << 16); }
__device__ __forceinline__ float bfhi(unsigned w) { return __builtin_bit_cast(float, w & 0xffff0000u); }
__device__ __forceinline__ float bf2f(unsigned short b) { return __builtin_bit_cast(float, (unsigned)b << 16); }
__device__ __forceinline__ f32x4 ld_bf4(const bf16* p) { const u32x2 w = *(const u32x2*)p; return (f32x4){bflo(w.x), bfhi(w.x), bflo(w.y), bfhi(w.y)}; }
__device__ __forceinline__ void st_bf4(bf16* p, f32x4 v) { u32x2 w; w.x = pk2(v[0], v[1]); w.y = pk2(v[2], v[3]); *(u32x2*)p = w; }
__device__ __forceinline__ void ld_bf8(const bf16* p, f32x4& a, f32x4& b) { const u32x4 w = *(const u32x4*)p; a = (f32x4){bflo(w.x), bfhi(w.x), bflo(w.y), bfhi(w.y)}; b = (f32x4){bflo(w.z), bfhi(w.z), bflo(w.w), bfhi(w.w)}; }
__device__ __forceinline__ void st_bf8(bf16* p, f32x4 a, f32x4 b) { u32x4 w; w.x = pk2(a[0], a[1]); w.y = pk2(a[2], a[3]); w.z = pk2(b[0], b[1]); w.w = pk2(b[2], b[3]); *(u32x4*)p = w; }
__device__ __forceinline__ float sigm(float x) { return __builtin_amdgcn_rcpf(1.f + __expf(-x)); }
__device__ __forceinline__ float gelu_tanh(float x) { const float t = 1.5957691216057308f * (x + 0.044715f * x * x * x); return x * __builtin_amdgcn_rcpf(1.f + __expf(-t)); }
__device__ __forceinline__ float wave_sum(float v) {
#pragma unroll
    for (int o = 1; o < 64; o <<= 1) v += __shfl_xor(v, o);
    return v;
}
__device__ __forceinline__ float wave_max(float v) {
#pragma unroll
    for (int o = 1; o < 64; o <<= 1) v = fmaxf(v, __shfl_xor(v, o));
    return v;
}

__device__ __forceinline__ int fresh_lane() { int l = (int)__builtin_amdgcn_mbcnt_hi(~0u, __builtin_amdgcn_mbcnt_lo(~0u, 0u)); asm volatile("" : "+v"(l)); return l; }

__device__ __forceinline__ void p0_transpose_item(const float* W, int K, int N, bf16* WT, int mode, const float* gk, float* scr, int item, int lane, int ldk = 0, int koff = 0) {
    if (ldk == 0) ldk = K;
    const int nblk = N / 32, kb = item / nblk, nb = item % nblk, k0 = 64 * kb, n0 = 32 * nb;
    float tv[32];
#pragma unroll
    for (int i = 0; i < 32; ++i) { const int kk = 2 * i + (lane >> 5); tv[i] = W[(size_t)(k0 + kk) * N + n0 + (lane & 31)]; }
    if (gk) {
#pragma unroll
        for (int i = 0; i < 32; ++i) tv[i] *= gk[k0 + 2 * i + (lane >> 5)];
    }
#pragma unroll
    for (int i = 0; i < 32; ++i) scr[(2 * i + (lane >> 5)) * 33 + (lane & 31)] = tv[i];
    LDS_WAIT();
    const int c = lane & 7;
#pragma unroll
    for (int j = 0; j < 4; ++j) { const int n = (lane >> 3) + 8 * j; const float* s = scr + (8 * c) * 33 + n;
        u32x4 o; o.x = pk2(s[0 * 33], s[1 * 33]); o.y = pk2(s[2 * 33], s[3 * 33]); o.z = pk2(s[4 * 33], s[5 * 33]); o.w = pk2(s[6 * 33], s[7 * 33]);
        const int nn = n0 + n; const int row = (mode == 0) ? nn : (((nn >> 7) << 8) + (mode == 2 ? 128 : 0) + (nn & 127));
        *(u32x4*)(WT + (size_t)row * ldk + koff + k0 + 8 * c) = o; }
    LDS_WAIT();
}

constexpr int P0_I0 = 16 * 104, P0_NITEMS = 16 * 104 + 8 * 16 + 8 * 32 + 8 * 32 + 16 * 32 + 16 * 88 + 16 * 88 + 44 * 32;
__device__ __forceinline__ void p0_weights(const Params& p, unsigned char* lds, int it0, int it1, int gw, int NGW, int wave, int lane) {
    unsigned char* ws = p.ws;
    float* scr = (float*)(lds + wave * 16384);
    constexpr int I0 = 16 * 104, I1 = 8 * 16, I2 = 8 * 32, I3 = 8 * 32, I4 = 16 * 32, I5 = 16 * 88, I6 = 16 * 88;
    for (int it = it0 + gw; it < it1; it += NGW) {
        int r = it;
        if (r < I0) { p0_transpose_item(p.in[I_WIN], 1024, INW, (bf16*)(ws + WS_WIN), 0, nullptr, scr, r, lane); continue; } r -= I0;
        if (r < I1) { p0_transpose_item(p.in[I_WGLU], 512, 512, (bf16*)(ws + WS_WGLU), 0, nullptr, scr, r, lane); continue; } r -= I1;
        if (r < I2) { p0_transpose_item(p.in[I_WBA], 512, 1024, (bf16*)(ws + WS_WBA), 0, nullptr, scr, r, lane, 1024, 0); continue; } r -= I2;
        if (r < I3) { p0_transpose_item(p.in[I_WBS], 512, 1024, (bf16*)(ws + WS_WBA), 0, nullptr, scr, r, lane, 1024, 512); continue; } r -= I3;
        if (r < I4) { p0_transpose_item(p.in[I_WOUT], 1024, 1024, (bf16*)(ws + WS_WOUT), 0, nullptr, scr, r, lane); continue; } r -= I4;
        if (r < I5) { p0_transpose_item(p.in[I_WFG], 1024, FF, (bf16*)(ws + WS_WGU), 1, p.in[I_N2G], scr, r, lane); continue; } r -= I5;
        if (r < I6) { p0_transpose_item(p.in[I_WFU], 1024, FF, (bf16*)(ws + WS_WGU), 2, p.in[I_N2G], scr, r, lane); continue; } r -= I6;
        p0_transpose_item(p.in[I_WFD], FF, 1024, (bf16*)(ws + WS_WD), 0, nullptr, scr, r, lane);
    }
}

__device__ __forceinline__ void p0_prologue(const Params& p, unsigned char* lds, int gw, int NGW, int wave, int lane) {
    unsigned char* ws = p.ws;
    bf16* xb = (bf16*)(ws + WS_XB);
    const f32x4* g4 = (const f32x4*)p.in[I_N1G];
    for (int m0 = 2 * gw; m0 < MR; m0 += 2 * NGW) {
        f32x4 v[2][4]; float s[2] = {0.f, 0.f};
#pragma unroll
        for (int r = 0; r < 2; ++r) {
            const int m = m0 + r;
            const float* xrow = (m < MPROMPT) ? p.in[I_XP] + (size_t)m * D : p.in[I_XS] + (size_t)(m - MPROMPT) * D;
            const f32x4* xr = (const f32x4*)xrow + 2 * lane;
#pragma unroll
            for (int j = 0; j < 2; ++j) { v[r][2 * j] = xr[128 * j]; v[r][2 * j + 1] = xr[128 * j + 1]; }
        }
#pragma unroll
        for (int r = 0; r < 2; ++r) {
#pragma unroll
            for (int j = 0; j < 4; ++j) s[r] += (v[r][j].x * v[r][j].x + v[r][j].y * v[r][j].y) + (v[r][j].z * v[r][j].z + v[r][j].w * v[r][j].w);
        }
#pragma unroll
        for (int r = 0; r < 2; ++r) {
            const int m = m0 + r;
            const float rstd = 1.f / sqrtf(wave_sum(s[r]) * (1.f / D) + EPS);
#pragma unroll
            for (int j = 0; j < 2; ++j) { const f32x4 ga = g4[2 * lane + 128 * j], gb = g4[2 * lane + 128 * j + 1];
                st_bf8(xb + (size_t)m * D + 8 * lane + 512 * j, v[r][2 * j] * rstd * ga, v[r][2 * j + 1] * rstd * gb); }
        }
    }
    const int gt = gw * 64 + lane, NGT = NGW * 64;
    for (int i = gt; i < 4097 * 8; i += NGT) {
        const int pi = i >> 3, fi = i & 7; const double pos = (pi == 4096) ? 8192.0 : (double)pi;
        const double invf[8] = {1.0, 0.19392274474868576, 0.03760603093086393, 0.007292664737217109, 0.001414213562373095, 0.0002742481756762073, 5.318295896944988e-05, 1.031338537721246e-05};
        double fsel = invf[0];
#pragma unroll
        for (int q = 1; q < 8; ++q) fsel = (fi == q) ? invf[q] : fsel;
        const double rev = pos * fsel * 0.15915494309189535; const double fr = rev - __builtin_rint(rev);
        const float a = (float)(fr * 6.283185307179586);
        ((f32x2*)(ws + WS_ROPE))[i] = (f32x2){cosf(a), sinf(a)};
    }
    for (int i = gw; i < 32 * 64; i += NGW) {
        const int g = i >> 6, pp = i & 63;
        const double dt = exp((double)p.in[I_LDT][g]); const double lr = (double)p.in[I_LRE][i], li = (double)p.in[I_LIM][i];
        const double mag = exp(lr * dt); double ang = li * dt; { const double rv = ang * 0.15915494309189535; ang = (rv - __builtin_rint(rv)) * 6.283185307179586; }
        const double lbr = mag * (double)cosf((float)ang), lbi = mag * (double)sinf((float)ang);
        if (lane == 0) ((f32x2*)(ws + WS_LBAR))[i] = (f32x2){(float)lbr, (float)lbi};
        if (lane == 0) { const double mS = exp(lr * dt * 256.0); double aS = li * dt * 256.0; const double rv = aS * 0.15915494309189535; aS = (rv - __builtin_rint(rv)) * 6.283185307179586;
          ((f32x2*)(ws + WS_LBARS))[i] = (f32x2){(float)(mS * (double)cosf((float)aS)), (float)(mS * (double)sinf((float)aS))}; }
        const double den = lr * lr + li * li, nr = lbr - 1.0;
        const float cr = (float)((nr * lr + lbi * li) / den), ci = (float)((lbi * lr - nr * li) / den);
        bf16* bbm = (bf16*)(ws + WS_BBM); f32x2* bbf = (f32x2*)(ws + WS_BBF); bf16* ccm = (bf16*)(ws + WS_CCM);
        if (lane < 16) { const int h = lane;
            const float br = p.in[I_BRE][i * 16 + h], bi = p.in[I_BIM][i * 16 + h];
            const float xr = cr * br - ci * bi, xi = cr * bi + ci * br;
            bbf[i * 16 + h] = (f32x2){xr, xi};
            bbm[(g * 128 + pp) * 16 + h] = (bf16)f2bf(xr); bbm[(g * 128 + 64 + pp) * 16 + h] = (bf16)f2bf(xi);
            const float c_r = p.in[I_CRE][(g * 16 + h) * 64 + pp], c_i = p.in[I_CIM][(g * 16 + h) * 64 + pp];
            ((unsigned*)ccm)[((g * 16 + h) * 128 + 2 * pp) >> 1] = pk2(c_r, -c_i);
        }
    }
}

struct EpiIn {
    static constexpr bool PERM = true, AFTER_DRAIN = false, HAS_MID = false, KHALVES = false; static constexpr int NF = 1;
    unsigned char* ws; const float* bgate; int cb0;
    __device__ __forceinline__ f32x4 do_rope(f32x4 x, int row, int fq) const {
        const int posidx = (row < MPROMPT) ? (row & 4095) : 4096;
        const f32x2* rp = (const f32x2*)(ws + WS_ROPE) + posidx * 8 + 4 * (fq & 1);
        f32x4 o;
#pragma unroll
        for (int e = 0; e < 4; ++e) { const float pv = __shfl_xor(x[e], 32); const f32x2 cs = rp[e]; o[e] = (fq < 2) ? (x[e] * cs.x - pv * cs.y) : (x[e] * cs.x + pv * cs.y); }
        return o;
    }
    __device__ __forceinline__ void elem(int row, int cb, int cl, f32x4 x, int fq, bool rope_frag) const {
        if (cb < 4) {
            if (rope_frag) x = do_rope(x, row, fq);
            st_bf4((bf16*)(ws + WS_Q) + (size_t)row * 512 + cb * 128 + cl, x * 0.125f);
        } else if (cb < 6) {
            if (cb == 4 && rope_frag) x = do_rope(x, row, fq);
            st_bf4((bf16*)(ws + (cb == 4 ? WS_K : WS_V)) + (size_t)row * 128 + cl, x);
        } else if (cb < 10) {
            st_bf4((bf16*)(ws + WS_U) + (size_t)row * 512 + (cb - 6) * 128 + cl, x);
        } else {
            const int c = (cb - 10) * 128 + cl; const f32x4 b = *(const f32x4*)(bgate + c);
            st_bf4((bf16*)(ws + WS_G) + (size_t)row * 2048 + c, (f32x4){sigm(x[0] + b[0]), sigm(x[1] + b[1]), sigm(x[2] + b[2]), sigm(x[3] + b[3])});
        }
    }
    __device__ __forceinline__ void rope8(f32x4& x0, f32x4& x1, int row, int fq) const {
        const int posidx = (row < MPROMPT) ? (row & 4095) : 4096;
        const f32x4* rp = (const f32x4*)((const f32x2*)(ws + WS_ROPE) + posidx * 8);
        const f32x4 c01 = rp[0], c23 = rp[1], c45 = rp[2], c67 = rp[3];
        const float cs[8] = {c01[0], c23[0], c45[0], c67[0], c01[2], c23[2], c45[2], c67[2]};
        const float sn[8] = {c01[1], c23[1], c45[1], c67[1], c01[3], c23[3], c45[3], c67[3]};
        const float sg = (fq == 0) ? -1.f : 1.f;
#pragma unroll
        for (int e = 0; e < 4; ++e) {
            const float p0 = __shfl_xor(x0[e], 16), p1 = __shfl_xor(x1[e], 16);
            const float r0 = x0[e] * (e == 0 ? c01[0] : e == 1 ? c01[2] : e == 2 ? c23[0] : c23[2]) + sg * p0 * (e == 0 ? c01[1] : e == 1 ? c01[3] : e == 2 ? c23[1] : c23[3]);
            const float r1 = x1[e] * (e == 0 ? c45[0] : e == 1 ? c45[2] : e == 2 ? c67[0] : c67[2]) + sg * p1 * (e == 0 ? c45[1] : e == 1 ? c45[3] : e == 2 ? c67[1] : c67[3]);
            x0[e] = (fq < 2) ? r0 : x0[e]; x1[e] = (fq < 2) ? r1 : x1[e];
        }
        (void)cs; (void)sn;
    }
    __device__ __forceinline__ void operator()(const f32x4 (&acc)[2][2][4][2], const pg8::Unit& un, int wr, int wc, int fr, int fq) const {
#pragma unroll
        for (int bj = 0; bj < 2; ++bj) {
            const int cb = cb0 + 2 * un.pn + bj;
            const int cl = 32 * wc + 8 * fq;
            f32x4 b0 = (f32x4){0.f, 0.f, 0.f, 0.f}, b1 = b0;
            if (cb >= 10) { b0 = *(const f32x4*)(bgate + (cb - 10) * 128 + cl); b1 = *(const f32x4*)(bgate + (cb - 10) * 128 + cl + 4); }
#pragma unroll
            for (int ai = 0; ai < 2; ++ai)
#pragma unroll
                for (int m = 0; m < 4; ++m) {
                    const int row = un.pm * 256 + ai * 128 + wr * 64 + m * 16 + fr;
                    f32x4 x0 = acc[ai][bj][m][0], x1 = acc[ai][bj][m][1];
                    if (cb < 4) {
                        if ((wc & 1) == 0) rope8(x0, x1, row, fq);
                        st_bf8((bf16*)(ws + WS_Q) + (size_t)row * 512 + cb * 128 + cl, x0 * 0.125f, x1 * 0.125f);
                    } else if (cb < 6) {
                        if (cb == 4 && (wc & 1) == 0) rope8(x0, x1, row, fq);
                        st_bf8((bf16*)(ws + (cb == 4 ? WS_K : WS_V)) + (size_t)row * 128 + cl, x0, x1);
                    } else if (cb < 10) {
                        st_bf8((bf16*)(ws + WS_U) + (size_t)row * 512 + (cb - 6) * 128 + cl, x0, x1);
                    } else {
                        const int c = (cb - 10) * 128 + cl;
                        st_bf8((bf16*)(ws + WS_G) + (size_t)row * 2048 + c, (f32x4){sigm(x0[0] + b0[0]), sigm(x0[1] + b0[1]), sigm(x0[2] + b0[2]), sigm(x0[3] + b0[3])},
                               (f32x4){sigm(x1[0] + b1[0]), sigm(x1[1] + b1[1]), sigm(x1[2] + b1[2]), sigm(x1[3] + b1[3])});
                    }
                }
        }
    }
    __device__ __forceinline__ void skinny(const f32x4 (&x)[1], int row, int n0, int fq) const { elem(row, cb0 + (n0 >> 7), (n0 & 127) + 4 * fq, x[0], fq, (n0 & 63) == 0); }
};

struct EpiGlu {
    static constexpr bool PERM = true, AFTER_DRAIN = false, HAS_MID = false, KHALVES = false; static constexpr int NF = 1;
    const bf16* z; bf16* so; const float* b;
    __device__ __forceinline__ void elem(int row, int c, f32x4 x) const {
        const f32x4 bb = *(const f32x4*)(b + c), zz = ld_bf4(z + (size_t)row * 512 + c);
        st_bf4(so + (size_t)row * 1024 + 512 + c, (f32x4){zz[0] * sigm(x[0] + bb[0]), zz[1] * sigm(x[1] + bb[1]), zz[2] * sigm(x[2] + bb[2]), zz[3] * sigm(x[3] + bb[3])});
    }
    __device__ __forceinline__ void operator()(const f32x4 (&acc)[2][2][4][2], const pg8::Unit& un, int wr, int wc, int fr, int fq) const {
#pragma unroll
        for (int ai = 0; ai < 2; ++ai)
#pragma unroll
            for (int m = 0; m < 4; ++m) {
                const int row = un.pm * 256 + ai * 128 + wr * 64 + m * 16 + fr;
#pragma unroll
                for (int bj = 0; bj < 2; ++bj) {
                    const int c = un.pn * 256 + bj * 128 + 32 * wc + 8 * fq;
                    const f32x4 x0 = acc[ai][bj][m][0], x1 = acc[ai][bj][m][1], b0 = *(const f32x4*)(b + c), b1 = *(const f32x4*)(b + c + 4);
                    f32x4 z0, z1; ld_bf8(z + (size_t)row * 512 + c, z0, z1);
                    st_bf8(so + (size_t)row * 1024 + 512 + c, (f32x4){z0[0] * sigm(x0[0] + b0[0]), z0[1] * sigm(x0[1] + b0[1]), z0[2] * sigm(x0[2] + b0[2]), z0[3] * sigm(x0[3] + b0[3])},
                           (f32x4){z1[0] * sigm(x1[0] + b1[0]), z1[1] * sigm(x1[1] + b1[1]), z1[2] * sigm(x1[2] + b1[2]), z1[3] * sigm(x1[3] + b1[3])});
                }
            }
    }
    __device__ __forceinline__ void skinny(const f32x4 (&x)[1], int row, int n0, int fq) const { elem(row, n0 + 4 * fq, x[0]); }
};

struct EpiMerge {
    static constexpr bool PERM = true, AFTER_DRAIN = false, HAS_MID = true, KHALVES = true; static constexpr int NF = 1;
    const bf16* g; bf16* mo;
    __device__ __forceinline__ void mid(f32x4 (&acc)[2][2][4][2], const pg8::Unit& un, int wr, int wc, int fr, int fq) const {
#pragma unroll
        for (int ai = 0; ai < 2; ++ai)
#pragma unroll
            for (int mp = 0; mp < 2; ++mp) {
                asm volatile("" ::: "memory");
                u32x4 w1[2][2], w2[2][2];
#pragma unroll
                for (int mm = 0; mm < 2; ++mm) {
                    const int row = un.pm * 256 + ai * 128 + wr * 64 + (2 * mp + mm) * 16 + fr;
#pragma unroll
                    for (int bj = 0; bj < 2; ++bj) {
                        const int c = un.pn * 256 + bj * 128 + 32 * wc + 8 * fq;
                        w1[mm][bj] = *(const u32x4*)(g + (size_t)row * 2048 + c); w2[mm][bj] = *(const u32x4*)(g + (size_t)row * 2048 + 1024 + c);
                    }
                }
#pragma unroll
                for (int mm = 0; mm < 2; ++mm)
#pragma unroll
                    for (int bj = 0; bj < 2; ++bj) {
                        const u32x4 a = w1[mm][bj], q = w2[mm][bj]; const int m = 2 * mp + mm;
                        const f32x4 p0 = (f32x4){bflo(a.x), bfhi(a.x), bflo(a.y), bfhi(a.y)}, p1 = (f32x4){bflo(a.z), bfhi(a.z), bflo(a.w), bfhi(a.w)};
                        const f32x4 q0 = (f32x4){bflo(q.x), bfhi(q.x), bflo(q.y), bfhi(q.y)}, q1 = (f32x4){bflo(q.z), bfhi(q.z), bflo(q.w), bfhi(q.w)};
                        f32x4 r0, r1;
#pragma unroll
                        for (int e = 0; e < 4; ++e) { r0[e] = p0[e] * __builtin_amdgcn_rcpf(q0[e]); r1[e] = p1[e] * __builtin_amdgcn_rcpf(q1[e]); }
                        acc[ai][bj][m][0] = acc[ai][bj][m][0] * r0; acc[ai][bj][m][1] = acc[ai][bj][m][1] * r1;
                    }
            }
    }
    __device__ __forceinline__ void operator()(const f32x4 (&acc)[2][2][4][2], const pg8::Unit& un, int wr, int wc, int fr, int fq) const {
#pragma unroll
        for (int ai = 0; ai < 2; ++ai)
#pragma unroll
            for (int m = 0; m < 4; ++m) {
                const int row = un.pm * 256 + ai * 128 + wr * 64 + m * 16 + fr;
#pragma unroll
                for (int bj = 0; bj < 2; ++bj) {
                    const int c = un.pn * 256 + bj * 128 + 32 * wc + 8 * fq;
                    f32x4 q0, q1; ld_bf8(g + (size_t)row * 2048 + 1024 + c, q0, q1);
                    st_bf8(mo + (size_t)row * D + c, acc[ai][bj][m][0] * q0, acc[ai][bj][m][1] * q1);
                }
            }
    }
    __device__ __forceinline__ void skinny(const f32x4 (&x)[2], int row, int n0, int fq) const {
        const int c = n0 + 4 * fq;
        st_bf4(mo + (size_t)row * D + c, x[0] * ld_bf4(g + (size_t)row * 2048 + c) + x[1] * ld_bf4(g + (size_t)row * 2048 + 1024 + c));
    }
};

template <int STEP> struct EpiRes {
    static constexpr bool PERM = (STEP == 0), AFTER_DRAIN = false, HAS_MID = false, KHALVES = false; static constexpr int NF = 1;
    const float *xp, *xs; float* out; bf16* xb; float* ss;
    __device__ __forceinline__ float elem(int row, int c, f32x4 x) const {
        if (STEP == 0) {
            const f32x4 r = (row < MPROMPT) ? *(const f32x4*)(xp + (size_t)row * D + c) : *(const f32x4*)(xs + (size_t)(row - MPROMPT) * D + c);
            x = x + r;
            st_bf4(xb + (size_t)row * D + c, x);
        } else {
            x = x + ld_bf4(xb + (size_t)row * D + c); st_bf4(xb + (size_t)row * D + c, x);
        }
        return (x[0] * x[0] + x[1] * x[1]) + (x[2] * x[2] + x[3] * x[3]);
    }
    __device__ __forceinline__ void operator()(const f32x4 (&acc)[2][2][4][2], const pg8::Unit& un, int wr, int wc, int fr, int fq) const {
#pragma unroll
        for (int ai = 0; ai < 2; ++ai)
#pragma unroll
            for (int m = 0; m < 4; ++m) {
                const int row = un.pm * 256 + ai * 128 + wr * 64 + m * 16 + fr;
                float s = 0.f;
                if constexpr (STEP == 0) {
#pragma unroll
                    for (int bj = 0; bj < 2; ++bj) {
                        const int c = un.pn * 256 + bj * 128 + 32 * wc + 8 * fq;
                        const float* xr = (row < MPROMPT) ? xp + (size_t)row * D + c : xs + (size_t)(row - MPROMPT) * D + c;
                        const f32x4 x0 = acc[ai][bj][m][0] + *(const f32x4*)xr, x1 = acc[ai][bj][m][1] + *(const f32x4*)(xr + 4);
                        st_bf8(xb + (size_t)row * D + c, x0, x1);
                        s += ((x0[0] * x0[0] + x0[1] * x0[1]) + (x0[2] * x0[2] + x0[3] * x0[3])) + ((x1[0] * x1[0] + x1[1] * x1[1]) + (x1[2] * x1[2] + x1[3] * x1[3]));
                    }
                } else {
#pragma unroll
                    for (int bj = 0; bj < 2; ++bj)
#pragma unroll
                        for (int n = 0; n < 2; ++n) s += elem(row, un.pn * 256 + bj * 128 + 32 * wc + 16 * n + 4 * fq, acc[ai][bj][m][n]);
                }
                s += __shfl_xor(s, 16); s += __shfl_xor(s, 32);
                if (fq == 0) atomicAdd(ss + row, s);
            }
    }
    __device__ __forceinline__ void skinny(const f32x4 (&x)[1], int row, int n0, int fq) const {
        float s = elem(row, n0 + 4 * fq, x[0]);
        s += __shfl_xor(s, 16); s += __shfl_xor(s, 32);
        if (fq == 0) atomicAdd(ss + row, s);
    }
};

struct EpiFinal {
    static constexpr bool PERM = true, AFTER_DRAIN = true, HAS_MID = false, KHALVES = false; static constexpr int NF = 1;
    const bf16* xb; float* out; float* ss; const float* gf; unsigned* cnt;
    __device__ __forceinline__ void operator()(const f32x4 (&)[2][2][4][2], const pg8::Unit&, int, int, int, int) const {}
    __device__ __forceinline__ void fused(f32x4 (&acc)[2][2][4][2], const pg8::Unit& un, int wr, int wc, int fr, int fq, PG8_LAS unsigned char*, int wid, int lane) const {
#pragma unroll
        for (int ai = 0; ai < 2; ++ai)
#pragma unroll
            for (int m = 0; m < 4; ++m) {
                const int row = un.pm * 256 + ai * 128 + wr * 64 + m * 16 + fr;
                float s = 0.f;
#pragma unroll
                for (int bj = 0; bj < 2; ++bj) {
                    const int c = un.pn * 256 + bj * 128 + 32 * wc + 8 * fq;
                    f32x4 r0, r1; ld_bf8(xb + (size_t)row * D + c, r0, r1);
                    const f32x4 x0 = acc[ai][bj][m][0] + r0, x1 = acc[ai][bj][m][1] + r1;
                    acc[ai][bj][m][0] = x0; acc[ai][bj][m][1] = x1;
                    s += ((x0[0] * x0[0] + x0[1] * x0[1]) + (x0[2] * x0[2] + x0[3] * x0[3])) + ((x1[0] * x1[0] + x1[1] * x1[1]) + (x1[2] * x1[2] + x1[3] * x1[3]));
                }
                s += __shfl_xor(s, 16); s += __shfl_xor(s, 32);
                if (fq == 0) atomicAdd(ss + row, s);
            }
        asm volatile("s_waitcnt vmcnt(0)" ::: "memory"); __syncthreads();
        if (wid == 0 && lane == 0) {
            __builtin_amdgcn_fence(__ATOMIC_RELEASE, "agent"); asm volatile("s_waitcnt vmcnt(0)" ::: "memory");
            __hip_atomic_fetch_add(cnt + 256 + 16 * un.pm, 1u, __ATOMIC_RELAXED, __HIP_MEMORY_SCOPE_AGENT);
            unsigned sp = 0;
            while (__hip_atomic_load(cnt + 256 + 16 * un.pm, __ATOMIC_RELAXED, __HIP_MEMORY_SCOPE_AGENT) < 4u && ++sp < (1u << 22)) __builtin_amdgcn_s_sleep(2);
            __builtin_amdgcn_fence(__ATOMIC_ACQUIRE, "agent"); asm volatile("s_waitcnt vmcnt(0)" ::: "memory");
        }
        __syncthreads();
#pragma unroll
        for (int ai = 0; ai < 2; ++ai)
#pragma unroll
            for (int m = 0; m < 4; ++m) {
                const int row = un.pm * 256 + ai * 128 + wr * 64 + m * 16 + fr;
                const float rstd = 1.f / sqrtf(__hip_atomic_load(ss + row, __ATOMIC_RELAXED, __HIP_MEMORY_SCOPE_AGENT) * (1.f / D) + EPS);
#pragma unroll
                for (int bj = 0; bj < 2; ++bj) {
                    const int c = un.pn * 256 + bj * 128 + 32 * wc + 8 * fq;
                    *(f32x4*)(out + (size_t)row * D + c) = acc[ai][bj][m][0] * rstd * *(const f32x4*)(gf + c);
                    *(f32x4*)(out + (size_t)row * D + c + 4) = acc[ai][bj][m][1] * rstd * *(const f32x4*)(gf + c + 4);
                }
            }
    }
};

struct EpiFfnUp {
    static constexpr bool PERM = true, AFTER_DRAIN = false, HAS_MID = false, KHALVES = false; static constexpr int NF = 2;
    const float* ss; bf16* act;
    __device__ __forceinline__ void elem(int row, int j, f32x4 gt, f32x4 up, float rstd) const {
        gt = gt * rstd; up = up * rstd;
        st_bf4(act + (size_t)row * FF + j, (f32x4){gt[0] * sigm(gt[0]) * up[0], gt[1] * sigm(gt[1]) * up[1], gt[2] * sigm(gt[2]) * up[2], gt[3] * sigm(gt[3]) * up[3]});
    }
    __device__ __forceinline__ void operator()(const f32x4 (&acc)[2][2][4][2], const pg8::Unit& un, int wr, int wc, int fr, int fq) const {
#pragma unroll
        for (int ai = 0; ai < 2; ++ai)
#pragma unroll
            for (int m = 0; m < 4; ++m) {
                const int row = un.pm * 256 + ai * 128 + wr * 64 + m * 16 + fr;
                const float rstd = 1.f / sqrtf(ss[row] * (1.f / D) + EPS);
                const int j = 128 * un.pn + 32 * wc + 8 * fq;
                const f32x4 g0 = acc[ai][0][m][0] * rstd, g1 = acc[ai][0][m][1] * rstd, u0 = acc[ai][1][m][0] * rstd, u1 = acc[ai][1][m][1] * rstd;
                st_bf8(act + (size_t)row * FF + j, (f32x4){g0[0] * sigm(g0[0]) * u0[0], g0[1] * sigm(g0[1]) * u0[1], g0[2] * sigm(g0[2]) * u0[2], g0[3] * sigm(g0[3]) * u0[3]},
                       (f32x4){g1[0] * sigm(g1[0]) * u1[0], g1[1] * sigm(g1[1]) * u1[1], g1[2] * sigm(g1[2]) * u1[2], g1[3] * sigm(g1[3]) * u1[3]});
            }
    }
    __device__ __forceinline__ void skinny(const f32x4 (&x)[2], int row, int j0, int fq) const {
        elem(row, j0 + 4 * fq, x[0], x[1], 1.f / sqrtf(ss[row] * (1.f / D) + EPS));
    }
};

template <class Epi, int K, int MQ> __device__ __forceinline__ void skinny_gemm(unsigned char* lds, const bf16* A, const bf16* Bt, int N, const Epi& E, int bx, int G, int wave, int lane, int lo) {
    constexpr int NF = Epi::NF, MFR = 8 / MQ, KS = K / 8, NSTEP = KS / 32;
    static_assert(KS % 32 == 0, "K slice per wave must be a multiple of 32");
    const int NP = (N / (16 * NF)) * MQ;
    if (bx < lo) return;
    const int fr = lane & 15, fq = lane >> 4;
    f32x4* red = (f32x4*)lds;
    for (int pc = G - 1 - bx; pc < NP; pc += G - lo) {
        const int mq = pc % MQ, pq = pc / MQ, r0 = MPROMPT + mq * 16 * MFR;
        const int n0 = (NF == 2) ? ((pq >> 3) * 256 + (pq & 7) * 16) : pq * 16;
        const int ncol = (NF == 2) ? pq * 16 : n0;
        const bf16* ap = A + (size_t)(r0 + fr) * K + wave * KS + 8 * fq;
        const bf16* bp = Bt + (size_t)(n0 + fr) * K + wave * KS + 8 * fq;
        bf16x8 bfr[NSTEP][NF], afr[NSTEP][MFR];
#pragma unroll
        for (int st = 0; st < NSTEP; ++st) {
#pragma unroll
            for (int nf = 0; nf < NF; ++nf) bfr[st][nf] = *(const bf16x8*)(bp + (size_t)((NF == 2 ? 128 : 16) * nf) * K + 32 * st);
#pragma unroll
            for (int mf = 0; mf < MFR; ++mf) afr[st][mf] = *(const bf16x8*)(ap + (size_t)(16 * mf) * K + 32 * st);
        }
        f32x4 acc[NF][MFR];
#pragma unroll
        for (int nf = 0; nf < NF; ++nf)
#pragma unroll
            for (int mf = 0; mf < MFR; ++mf) acc[nf][mf] = (f32x4){0.f, 0.f, 0.f, 0.f};
#pragma unroll
        for (int st = 0; st < NSTEP; ++st)
#pragma unroll
            for (int nf = 0; nf < NF; ++nf)
#pragma unroll
                for (int mf = 0; mf < MFR; ++mf) acc[nf][mf] = __builtin_amdgcn_mfma_f32_16x16x32_bf16(bfr[st][nf], afr[st][mf], acc[nf][mf], 0, 0, 0);
#pragma unroll
        for (int nf = 0; nf < NF; ++nf)
#pragma unroll
            for (int mf = 0; mf < MFR; ++mf) red[((wave * NF + nf) * MFR + mf) * 64 + lane] = acc[nf][mf];
        __syncthreads();
        if (wave < MFR) {
            if constexpr (Epi::KHALVES) {
                f32x4 x[2];
#pragma unroll
                for (int hf = 0; hf < 2; ++hf) {
                    f32x4 t = red[((4 * hf) * MFR + wave) * 64 + lane];
#pragma unroll
                    for (int w = 1; w < 4; ++w) t = t + red[((4 * hf + w) * MFR + wave) * 64 + lane];
                    x[hf] = t;
                }
                E.skinny(x, r0 + 16 * wave + fr, ncol, fq);
            } else {
                f32x4 x[NF];
#pragma unroll
                for (int nf = 0; nf < NF; ++nf) {
                    f32x4 t = red[((0 * NF + nf) * MFR + wave) * 64 + lane];
#pragma unroll
                    for (int w = 1; w < 8; ++w) t = t + red[((w * NF + nf) * MFR + wave) * 64 + lane];
                    x[nf] = t;
                }
                E.skinny(x, r0 + 16 * wave + fr, ncol, fq);
            }
        }
        __syncthreads();
    }
}

__device__ __forceinline__ void attn_prompt_item(const Params& p, unsigned char* lds, int item, int tid, bf16* obuf) {
    unsigned char* ws = p.ws;
    const int kvh = item & 1, n = (item >> 1) & 31, b = item >> 6;
    bf16* Ks = (bf16*)lds;
    bf16* VT = (bf16*)(lds + 36864);
    const bf16* kbuf = (const bf16*)(ws + WS_K); const bf16* vbuf = (const bf16*)(ws + WS_V); bf16* qbuf = (bf16*)(ws + WS_Q);
    u32x4 kka[4], vva[4];
#pragma unroll
    for (int i = 0; i < 4; ++i) {
        const int c = tid + NTHREADS * i, r = c >> 3, ch = c & 7; const int trow = (n - 1) * 128 + r;
        kka[i] = (u32x4){0u, 0u, 0u, 0u}; vva[i] = kka[i];
        if (trow >= 0) { const size_t go = (size_t)(b * TPR + trow) * 128 + kvh * 64 + ch * 8; kka[i] = *(const u32x4*)(kbuf + go); vva[i] = *(const u32x4*)(vbuf + go); }
    }
#pragma unroll
    for (int i = 0; i < 4; ++i) {
        const int c = tid + NTHREADS * i, r = c >> 3, ch = c & 7;
        const u32x4 kk = kka[i], vv = vva[i];
        *(u32x4*)(Ks + r * 72 + ch * 8) = kk;
        if (n == 31 && r >= 128) {
            float* ko = p.out + O_KWP + ((size_t)(b * 128 + (r - 128)) * 2 + kvh) * 64 + ch * 8; float* vo = p.out + O_VWP + ((size_t)(b * 128 + (r - 128)) * 2 + kvh) * 64 + ch * 8;
            *(f32x4*)ko = (f32x4){bflo(kk.x), bfhi(kk.x), bflo(kk.y), bfhi(kk.y)}; *(f32x4*)(ko + 4) = (f32x4){bflo(kk.z), bfhi(kk.z), bflo(kk.w), bfhi(kk.w)};
            *(f32x4*)vo = (f32x4){bflo(vv.x), bfhi(vv.x), bflo(vv.y), bfhi(vv.y)}; *(f32x4*)(vo + 4) = (f32x4){bflo(vv.z), bfhi(vv.z), bflo(vv.w), bfhi(vv.w)};
        }
        bf16* vd = VT + (ch * 8) * 264 + r;
        vd[0 * 264] = (bf16)(vv.x & 0xffffu); vd[1 * 264] = (bf16)(vv.x >> 16); vd[2 * 264] = (bf16)(vv.y & 0xffffu); vd[3 * 264] = (bf16)(vv.y >> 16);
        vd[4 * 264] = (bf16)(vv.z & 0xffffu); vd[5 * 264] = (bf16)(vv.z >> 16); vd[6 * 264] = (bf16)(vv.w & 0xffffu); vd[7 * 264] = (bf16)(vv.w >> 16);
    }
    __syncthreads();
    const int wave = tid >> 6, lane = tid & 63, fr = lane & 15, fq = lane >> 4;
    const int i0 = 16 * wave, kb = i0 < 96 ? i0 : 96;
    const int qi = i0 + fr;
    const size_t qrow = (size_t)(b * TPR + n * 128 + qi);
    const int jlo = (n == 0) ? (qi + 1 > 128 ? qi + 1 : 128) : qi + 1; const int jbase = kb + 4 * fq - jlo; const unsigned jlim = (unsigned)(qi + 128 - jlo);
    bf16x8 qn0 = *(const bf16x8*)(qbuf + qrow * 512 + kvh * 256 + 8 * fq), qn1 = *(const bf16x8*)(qbuf + qrow * 512 + kvh * 256 + 8 * fq + 32);
#pragma unroll 1
    for (int hh = 0; hh < 4; ++hh) {
        const int h = kvh * 4 + hh;
        const float sink = p.in[I_SINK][h];
        bf16* qp = qbuf + qrow * 512 + h * 64;
        const bf16x8 q0 = qn0, q1 = qn1;
        asm volatile("" ::: "memory");
        { const bf16* qnx = qbuf + qrow * 512 + (kvh * 4 + (hh < 3 ? hh + 1 : 3)) * 64; qn0 = *(const bf16x8*)(qnx + 8 * fq); qn1 = *(const bf16x8*)(qnx + 8 * fq + 32); }
        f32x4 s[10];
#pragma unroll
        for (int f = 0; f < 10; ++f) {
            const bf16* kp = Ks + (kb + 16 * f + fr) * 72 + 8 * fq;
            f32x4 a = (f32x4){0.f, 0.f, 0.f, 0.f};
            a = __builtin_amdgcn_mfma_f32_16x16x32_bf16(*(const bf16x8*)kp, q0, a, 0, 0, 0);
            a = __builtin_amdgcn_mfma_f32_16x16x32_bf16(*(const bf16x8*)(kp + 32), q1, a, 0, 0, 0);
            s[f] = a;
        }
        float mx = sink;
#pragma unroll
        for (int f = 0; f < 10; ++f)
#pragma unroll
            for (int r = 0; r < 4; ++r) { const bool ok = (unsigned)(jbase + 16 * f + r) <= jlim;
                s[f][r] = ok ? s[f][r] : -__builtin_inff(); mx = fmaxf(mx, s[f][r]); }
        mx = fmaxf(mx, __shfl_xor(mx, 16)); mx = fmaxf(mx, __shfl_xor(mx, 32));
        float sum = 0.f;
#pragma unroll
        for (int f = 0; f < 10; ++f)
#pragma unroll
            for (int r = 0; r < 4; ++r) { const float e = __expf(s[f][r] - mx); s[f][r] = e; sum += e; }
        sum += __shfl_xor(sum, 16); sum += __shfl_xor(sum, 32);
        sum += __expf(sink - mx);
        const float inv = 1.f / sum;
        bf16x8 pb[5];
#pragma unroll
        for (int m = 0; m < 5; ++m) { u32x4 w; w.x = pk2(s[2 * m][0], s[2 * m][1]); w.y = pk2(s[2 * m][2], s[2 * m][3]); w.z = pk2(s[2 * m + 1][0], s[2 * m + 1][1]); w.w = pk2(s[2 * m + 1][2], s[2 * m + 1][3]);
            pb[m] = __builtin_bit_cast(bf16x8, w); }
#pragma unroll
        for (int df = 0; df < 4; ++df) {
            f32x4 o = (f32x4){0.f, 0.f, 0.f, 0.f};
            const bf16* vp = VT + (16 * df + fr) * 264 + kb + 4 * fq;
#pragma unroll
            for (int m = 0; m < 5; ++m) {
                const u32x2 lo = *(const u32x2*)(vp + 32 * m), hi = *(const u32x2*)(vp + 32 * m + 16);
                const u32x4 w = (u32x4){lo.x, lo.y, hi.x, hi.y};
                o = __builtin_amdgcn_mfma_f32_16x16x32_bf16(__builtin_bit_cast(bf16x8, w), pb[m], o, 0, 0, 0);
            }
            st_bf4(obuf + qrow * 1024 + h * 64 + 16 * df + 4 * fq, o * inv);
        }
    }
    __syncthreads();
}

__device__ __forceinline__ void attn_sample_block(const Params& p, unsigned char* lds, int item, int tid) {
    unsigned char* ws = p.ws;
    const int kvh = item & 1, db = item >> 1, lane = tid & 63, wave = tid >> 6;
    float* qs = (float*)lds;
    float* sc = (float*)(lds + 1024);
    float* red = (float*)(lds + 3072);
    bf16* qbuf = (bf16*)(ws + WS_Q);
    const size_t row = (size_t)(MPROMPT + db);
    if (tid < 256) qs[tid] = bf2f(qbuf[row * 512 + kvh * 256 + tid]);
    const int key = tid >> 2, part = tid & 3;
    f32x4 kv[4];
    {
        float* dst = p.out + O_KWS + ((size_t)(db * 128 + key) * 2 + kvh) * 64 + part * 16;
        if (key < 127) {
            const float* src = p.in[I_SK] + ((size_t)(db * 128 + key + 1) * 2 + kvh) * 64 + part * 16;
#pragma unroll
            for (int c = 0; c < 4; ++c) kv[c] = *(const f32x4*)(src + 4 * c);
        } else {
            const bf16* src = (const bf16*)(ws + WS_K) + row * 128 + kvh * 64 + part * 16;
#pragma unroll
            for (int c = 0; c < 4; ++c) kv[c] = ld_bf4(src + 4 * c);
        }
#pragma unroll
        for (int c = 0; c < 4; ++c) *(f32x4*)(dst + 4 * c) = kv[c];
    }
    __syncthreads();
    {
        float a[4];
#pragma unroll
        for (int hh = 0; hh < 4; ++hh) {
            float t = 0.f;
#pragma unroll
            for (int c = 0; c < 4; ++c) { const f32x4 w = *(const f32x4*)(qs + hh * 64 + part * 16 + 4 * c); t += kv[c][0] * w[0] + kv[c][1] * w[1] + kv[c][2] * w[2] + kv[c][3] * w[3]; }
            t += __shfl_xor(t, 1); t += __shfl_xor(t, 2); a[hh] = t;
        }
        if (part == 0) { sc[key] = a[0]; sc[128 + key] = a[1]; sc[256 + key] = a[2]; sc[384 + key] = a[3]; }
    }
    __syncthreads();
    if (wave < 4) {
        const float sink = p.in[I_SINK][kvh * 4 + wave];
        const float s0 = sc[wave * 128 + lane], s1 = sc[wave * 128 + 64 + lane];
        const float mx = fmaxf(wave_max(fmaxf(s0, s1)), sink);
        const float e0 = __expf(s0 - mx), e1 = __expf(s1 - mx);
        const float inv = 1.f / (wave_sum(e0 + e1) + __expf(sink - mx));
        sc[wave * 128 + lane] = e0 * inv; sc[wave * 128 + 64 + lane] = e1 * inv;
    }
    __syncthreads();
    {
        const int chunk = tid & 15, kg = tid >> 4;
        f32x4 vv[4];
#pragma unroll
        for (int i = 0; i < 4; ++i) {
            const int k2 = kg * 4 + i;
            if (k2 < 127) vv[i] = *(const f32x4*)(p.in[I_SV] + ((size_t)(db * 128 + k2 + 1) * 2 + kvh) * 64 + chunk * 4);
            else vv[i] = ld_bf4((const bf16*)(ws + WS_V) + row * 128 + kvh * 64 + chunk * 4);
            *(f32x4*)(p.out + O_VWS + ((size_t)(db * 128 + k2) * 2 + kvh) * 64 + chunk * 4) = vv[i];
        }
        f32x4 o[4];
#pragma unroll
        for (int hh = 0; hh < 4; ++hh) {
            f32x4 t = (f32x4){0.f, 0.f, 0.f, 0.f};
#pragma unroll
            for (int i = 0; i < 4; ++i) t = t + vv[i] * sc[hh * 128 + kg * 4 + i];
#pragma unroll
            for (int e = 0; e < 4; ++e) { t[e] += __shfl_xor(t[e], 16); t[e] += __shfl_xor(t[e], 32); }
            o[hh] = t;
        }
        if (lane < 16) {
#pragma unroll
            for (int hh = 0; hh < 4; ++hh) *(f32x4*)(red + (wave * 4 + hh) * 64 + chunk * 4) = o[hh];
        }
    }
    __syncthreads();
    if (tid < 256) {
        float t = 0.f;
#pragma unroll
        for (int w = 0; w < 8; ++w) t += red[w * 256 + tid];
        ((bf16*)(ws + WS_AS))[row * 1024 + kvh * 256 + tid] = (bf16)f2bf(t);
    }
    __syncthreads();
}

template <bool PB> __device__ __forceinline__ void ssm_item(const Params& p, unsigned char* ldsw, int item, int lane) {
    unsigned char* ws = p.ws;
    const int seg = item & 15, g = (item >> 4) & 31, b = item >> 9;
    const int fr = lane & 15, fq = lane >> 4;
    float* BuT = (float*)ldsw;
    bf16* hc = (bf16*)(ldsw + 10240);
    const f32x2 lb = ((const f32x2*)(ws + WS_LBAR))[g * 64 + lane];
    const bf16* bbm = (const bf16*)(ws + WS_BBM); const bf16* ccm = (const bf16*)(ws + WS_CCM);
    bf16x4 bb[8];
#pragma unroll
    for (int f = 0; f < 8; ++f) bb[f] = *(const bf16x4*)(bbm + ((size_t)(g * 128 + 16 * f + fr) * 16 + 4 * fq));
    bf16x8 cc[4]; f32x4 dv = (f32x4){0.f, 0.f, 0.f, 0.f};
    if (PB) {
#pragma unroll
        for (int s = 0; s < 4; ++s) cc[s] = *(const bf16x8*)(ccm + ((size_t)(g * 16 + fr) * 128 + 8 * fq + 32 * s));
        dv = *(const f32x4*)(p.in[I_SD] + g * 16 + 4 * fq);
    }
    float hr = 0.f, hi = 0.f;
    f32x2* E = (f32x2*)(ws + WS_E);
    if (PB) {
        const f32x2 ls = ((const f32x2*)(ws + WS_LBARS))[g * 64 + lane];
        f32x2 ev[15];
#pragma unroll
        for (int j = 0; j < 15; ++j) ev[j] = E[((size_t)((b * 32 + g) * 16 + (j < seg ? j : 0))) * 64 + lane];
#pragma unroll
        for (int j = 0; j < 15; ++j) { const float nr = ls.x * hr - ls.y * hi + ev[j].x, ni = ls.x * hi + ls.y * hr + ev[j].y; hr = (j < seg) ? nr : hr; hi = (j < seg) ? ni : hi; }
    }
    const size_t row0 = (size_t)b * TPR + seg * 256;
    const bf16* up = (const bf16*)(ws + WS_U) + (row0 + fr) * 512 + g * 16 + 4 * fq;
    bf16* zb = (bf16*)(ws + WS_Z);
    u32x2 uw_n = *(const u32x2*)up;
    for (int ch = 0; ch < 16; ++ch) {
        const u32x2 uw = uw_n;
        uw_n = *(const u32x2*)(up + (size_t)(ch < 15 ? ch + 1 : 15) * 16 * 512);
        const bf16x4 ua = __builtin_bit_cast(bf16x4, uw);
#pragma unroll
        for (int f = 0; f < 8; ++f) {
            f32x4 a = (f32x4){0.f, 0.f, 0.f, 0.f};
            a = __builtin_amdgcn_mfma_f32_16x16x16bf16_1k(ua, bb[f], a, 0, 0, 0);
            *(f32x4*)(BuT + (16 * f + fr) * 20 + 4 * fq) = a;
        }
        LDS_WAIT();
#pragma unroll
        for (int j = 0; j < 4; ++j) {
            const f32x4 r4 = *(const f32x4*)(BuT + lane * 20 + 4 * j), i4 = *(const f32x4*)(BuT + (64 + lane) * 20 + 4 * j);
#pragma unroll
            for (int e = 0; e < 4; ++e) {
                const float nr = lb.x * hr - lb.y * hi + r4[e], ni = lb.x * hi + lb.y * hr + i4[e]; hr = nr; hi = ni;
                if (PB) *(unsigned*)(hc + (4 * j + e) * 136 + 2 * lane) = pk2(hr, hi);
            }
        }
        if (PB) {
            LDS_WAIT();
            f32x4 y = (f32x4){0.f, 0.f, 0.f, 0.f};
#pragma unroll
            for (int s = 0; s < 4; ++s) y = __builtin_amdgcn_mfma_f32_16x16x32_bf16(cc[s], *(const bf16x8*)(hc + fr * 136 + 8 * fq + 32 * s), y, 0, 0, 0);
            const f32x4 uf = (f32x4){bflo(uw.x), bfhi(uw.x), bflo(uw.y), bfhi(uw.y)};
            y = y + dv * uf;
            st_bf4(zb + (row0 + ch * 16 + fr) * 512 + g * 16 + 4 * fq, (f32x4){gelu_tanh(y[0]), gelu_tanh(y[1]), gelu_tanh(y[2]), gelu_tanh(y[3])});
        }
        LDS_WAIT();
    }
    if (!PB) E[((size_t)((b * 32 + g) * 16 + seg)) * 64 + lane] = (f32x2){hr, hi};
    else if (seg == NSEG - 1) { p.out[O_SRP + (size_t)(b * 32 + g) * 64 + lane] = hr; p.out[O_SIP + (size_t)(b * 32 + g) * 64 + lane] = hi; }
}

template <int NI> __device__ __forceinline__ void ssm_sample_items(const Params& p, unsigned char* ldsw, int item0, int istep, int lane) {
    unsigned char* ws = p.ws;
    float* hs = (float*)ldsw;
    const int ho = lane & 15, part = lane >> 4;
    u32x4 u0[NI], u1[NI]; f32x4 bw[NI][8]; f32x2 lb[NI]; float h0r[NI], h0i[NI], dsk[NI]; f32x4 crr[NI][4], cii[NI][4];
#pragma unroll
    for (int k = 0; k < NI; ++k) {
        const int item = item0 + k * istep, g = item & 31, db = item >> 5;
        const bf16* up = (const bf16*)(ws + WS_U) + (size_t)(MPROMPT + db) * 512 + g * 16;
        u0[k] = *(const u32x4*)up; u1[k] = *(const u32x4*)(up + 8);
        const f32x4* bbf = (const f32x4*)((const f32x2*)(ws + WS_BBF) + (size_t)(g * 64 + lane) * 16);
#pragma unroll
        for (int h = 0; h < 8; ++h) bw[k][h] = bbf[h];
        lb[k] = ((const f32x2*)(ws + WS_LBAR))[g * 64 + lane];
        h0r[k] = p.in[I_SRE][(size_t)(db * 32 + g) * 64 + lane]; h0i[k] = p.in[I_SIM][(size_t)(db * 32 + g) * 64 + lane];
        const f32x4* cr = (const f32x4*)(p.in[I_CRE] + (size_t)(g * 16 + ho) * 64 + part * 16); const f32x4* ci = (const f32x4*)(p.in[I_CIM] + (size_t)(g * 16 + ho) * 64 + part * 16);
#pragma unroll
        for (int q = 0; q < 4; ++q) { crr[k][q] = cr[q]; cii[k][q] = ci[q]; }
        dsk[k] = p.in[I_SD][g * 16 + ho];
    }
    float uo[NI];
#pragma unroll
    for (int k = 0; k < NI; ++k) {
        const int item = item0 + k * istep, g = item & 31, db = item >> 5;
        const float uf[16] = {bflo(u0[k].x), bfhi(u0[k].x), bflo(u0[k].y), bfhi(u0[k].y), bflo(u0[k].z), bfhi(u0[k].z), bflo(u0[k].w), bfhi(u0[k].w),
                              bflo(u1[k].x), bfhi(u1[k].x), bflo(u1[k].y), bfhi(u1[k].y), bflo(u1[k].z), bfhi(u1[k].z), bflo(u1[k].w), bfhi(u1[k].w)};
        float br = 0.f, bi = 0.f;
#pragma unroll
        for (int h = 0; h < 8; ++h) { const f32x4 w = bw[k][h]; br += w[0] * uf[2 * h] + w[2] * uf[2 * h + 1]; bi += w[1] * uf[2 * h] + w[3] * uf[2 * h + 1]; }
        const float hr = lb[k].x * h0r[k] - lb[k].y * h0i[k] + br, hi = lb[k].x * h0i[k] + lb[k].y * h0r[k] + bi;
        p.out[O_SRS + (size_t)(db * 32 + g) * 64 + lane] = hr; p.out[O_SIS + (size_t)(db * 32 + g) * 64 + lane] = hi;
        hs[k * 128 + lane] = hr; hs[k * 128 + 64 + lane] = hi;
        float t = uf[0];
#pragma unroll
        for (int q = 1; q < 16; ++q) t = (ho == q) ? uf[q] : t;
        uo[k] = t;
    }
    LDS_WAIT();
#pragma unroll
    for (int k = 0; k < NI; ++k) {
        const int item = item0 + k * istep, g = item & 31, db = item >> 5;
        const f32x4* hr4 = (const f32x4*)(hs + k * 128 + part * 16); const f32x4* hi4 = (const f32x4*)(hs + k * 128 + 64 + part * 16);
        const f32x4 t = crr[k][0] * hr4[0] + crr[k][1] * hr4[1] + crr[k][2] * hr4[2] + crr[k][3] * hr4[3] - cii[k][0] * hi4[0] - cii[k][1] * hi4[1] - cii[k][2] * hi4[2] - cii[k][3] * hi4[3];
        float y = (t[0] + t[1]) + (t[2] + t[3]);
        y += __shfl_xor(y, 16); y += __shfl_xor(y, 32);
        y += dsk[k] * uo[k];
        if (part == 0) ((bf16*)(ws + WS_Z))[(size_t)(MPROMPT + db) * 512 + g * 16 + ho] = (bf16)f2bf(gelu_tanh(y));
    }
    LDS_WAIT();
}

#define XB_TMO      128
#define XB_XCNT(j)  (256  + 64 * (j))
#define XB_XSUB(j)  (1280 + 64 * (j))
#define XB_XGEN(j)  (2304 + 64 * (j))
#define XB_TOP      3328
#define XB_TOPGEN   3392
#define XCD_BAR_WORDS 3456
#define XB_SPIN_CAP (1u << 18)

__device__ __forceinline__ unsigned xb_ld(unsigned* p)              { return __hip_atomic_load(p, __ATOMIC_RELAXED, __HIP_MEMORY_SCOPE_AGENT); }
__device__ __forceinline__ unsigned xb_add(unsigned* p, unsigned v) { return __hip_atomic_fetch_add(p, v, __ATOMIC_RELAXED, __HIP_MEMORY_SCOPE_AGENT); }
__device__ __forceinline__ unsigned xb_xcc_id() { return (unsigned)__builtin_amdgcn_s_getreg((3 << 11) | 20) & 0xFu; }
#define XB_SPIN(cond, bar) do { unsigned _sp = 0; while (cond) { __builtin_amdgcn_s_sleep(1); \
    if ((++_sp & 255u) == 0u) { if (xb_ld(&(bar)[XB_TMO])) break; if (_sp > XB_SPIN_CAP) { atomicAdd(&(bar)[XB_TMO], 1u); break; } } } } while (0)

struct XcdBarrier {
    unsigned* bar; unsigned x;
    volatile LAS unsigned* st;
};

__device__ __forceinline__ XcdBarrier xcd_barrier_post(unsigned* bar, volatile LAS unsigned* st) {
    XcdBarrier b; b.bar = bar; b.x = xb_xcc_id(); b.st = st;
    if (threadIdx.x == 0) (void)xb_add(&bar[XB_XCNT(b.x)], 1u);
    return b;
}
__device__ __forceinline__ void xcd_barrier_complete(unsigned* bar, unsigned x, unsigned& nloc, unsigned& nx) {
    const unsigned G = gridDim.x * gridDim.y * gridDim.z;
    unsigned sum, cnt, mine, sp = 0u;
    for (;;) {
        sum = 0u; cnt = 0u; mine = 0u;
#pragma unroll
        for (unsigned j = 0; j < 16; ++j) { const unsigned c = xb_ld(&bar[XB_XCNT(j)]); sum += c; cnt += (c > 0u) ? 1u : 0u; mine = (j == x) ? c : mine; }
        if (sum == G) break;
        __builtin_amdgcn_s_sleep(1);
        if ((++sp & 255u) == 0u) { if (xb_ld(&bar[XB_TMO])) break; if (sp > XB_SPIN_CAP) { atomicAdd(&bar[XB_TMO], 1u); break; } }
    }
    nloc = mine > 0u ? mine : 1u; nx = cnt > 0u ? cnt : 1u;
}

__device__ __forceinline__ void xcd_barrier(const XcdBarrier& b, const bool is_t0) {
    asm volatile("s_waitcnt vmcnt(0)" ::: "memory");
    __syncthreads();
    if (is_t0) {
        unsigned* bar = b.bar;
        __builtin_amdgcn_s_waitcnt(0);
        unsigned nloc = b.st[0], nx = b.st[1];
        if (nloc == 0u) { xcd_barrier_complete(bar, b.x, nloc, nx); b.st[0] = nloc; b.st[1] = nx; }
        const unsigned old = xb_add(&bar[XB_XSUB(b.x)], 1u);
        const unsigned gen = old / nloc;
        if (old + 1u == (gen + 1u) * nloc) {
            __builtin_amdgcn_fence(__ATOMIC_RELEASE, "agent");
            asm volatile("s_waitcnt vmcnt(0)" ::: "memory");
            const unsigned og = xb_add(&bar[XB_TOP], 1u);
            const unsigned tg = og / nx;
            if (og + 1u == (tg + 1u) * nx) xb_add(&bar[XB_TOPGEN], 1u);
            else XB_SPIN(xb_ld(&bar[XB_TOPGEN]) == tg, bar);
            __builtin_amdgcn_fence(__ATOMIC_ACQUIRE, "agent");
            xb_add(&bar[XB_XGEN(b.x)], 1u);
            asm volatile("s_waitcnt vmcnt(0)" ::: "memory");
        } else {
            XB_SPIN(xb_ld(&bar[XB_XGEN(b.x)]) == gen, bar);
            __builtin_amdgcn_fence(__ATOMIC_ACQUIRE, "agent");
            asm volatile("s_waitcnt vmcnt(0)" ::: "memory");
        }
    }
    __syncthreads();
}

#ifndef XPROBE
#define XPROBE 0
#endif
#ifndef DUP
#define DUP 0
#endif
#ifndef P2S
#define P2S 15
#endif
#ifndef PH
#define PH 0x3ff
#endif
__global__ void __launch_bounds__(NTHREADS, 2) mk_fwd(Params p) {
    extern __shared__ __attribute__((aligned(16))) unsigned char lds[];
    cg::grid_group grid = cg::this_grid();
    const int wave = __builtin_amdgcn_readfirstlane(threadIdx.x >> 6);
    const int G = gridDim.x, bx = blockIdx.x;
    const int gw = bx * NWAVES + wave, NGW = G * NWAVES;
    unsigned char* ws = p.ws;
    PG8_LAS unsigned char* ldsg = (PG8_LAS unsigned char*)lds;
    if (gridDim.x == 0x7fffffffu) grid.sync();
    if (threadIdx.x < 4) ((volatile LAS unsigned*)(ldsg + 131072 + 64))[threadIdx.x] = 0u;
    __syncthreads();
    (void)xcd_barrier_post((unsigned*)(ws + WS_BAR), (volatile LAS unsigned*)(ldsg + 131072 + 64));
#define GRID_BAR() do { XcdBarrier b_; b_.bar = (unsigned*)(p.ws + WS_BAR); b_.x = xb_xcc_id(); b_.st = (volatile LAS unsigned*)(ldsg + 131072 + 64); xcd_barrier(b_, wave == 0 && fresh_lane() == 0); } while (0)

#if PH & (1<<0)
    for (int rep_ = 0; rep_ < 1 + ((DUP >> 0) & 1); ++rep_) {
    { int lane_ = fresh_lane();
    p0_weights(p, lds, 0, P0_I0 + 8 * 16, gw, NGW, wave, lane_);
    p0_prologue(p, lds, gw, NGW, wave, lane_); }
    GRID_BAR();

    }
#endif
#if PH & (1<<1)
    for (int rep_ = 0; rep_ < 1 + ((DUP >> 1) & 1); ++rep_) {
    {
        pg8::Gemm g{(const bf16*)(ws + WS_XB), (const bf16*)(ws + WS_WIN), MPROMPT, 3072, D}; pg8::StaticOrder S; S.init(MPROMPT, 3072, G, bx);
        EpiIn E{ws, p.in[I_BG], 0};
        { int lane_ = fresh_lane(); skinny_gemm<EpiIn, 1024, 1>(lds, g.A, g.Bt, 3072, E, bx, G, wave, lane_, 0); }
        pg8::gemm_phase<EpiIn, pg8::StaticOrder, true, true>(ldsg, g, S, E, wave, wave * 64 + fresh_lane());
    }
    GRID_BAR();

    }
#endif
#if PH & (1<<2)
    for (int rep_ = 0; rep_ < 1 + ((DUP >> 2) & 1); ++rep_) {
#if P2S & 1
#if XPROBE & 1
    for (int it = bx; it < 256; it += G) { int tid_ = wave * 64 + fresh_lane(); attn_prompt_item(p, lds, it, tid_, (bf16*)(ws + WS_M)); }
#endif
    for (int it = bx; it < 256; it += G) { int tid_ = wave * 64 + fresh_lane(); attn_prompt_item(p, lds, it, tid_, (bf16*)(ws + WS_AS)); }
    }
#endif
#if P2S & 2
    for (int it = bx; it < 256; it += G) { int tid_ = wave * 64 + fresh_lane(); attn_sample_block(p, lds, it, tid_); }
#endif
#if XPROBE & 2
    for (int it = gw; it < 2048; it += NGW) { int lane_ = fresh_lane(); ssm_item<false>(p, lds + wave * 16384, it, lane_); }
    { int it = gw; for (; it + NGW < 4096; it += 2 * NGW) { int lane_ = fresh_lane(); ssm_sample_items<2>(p, lds + wave * 16384, it, NGW, lane_); }
      if (it < 4096) { int lane_ = fresh_lane(); ssm_sample_items<1>(p, lds + wave * 16384, it, NGW, lane_); } }
#endif
#if P2S & 4
    for (int it = gw; it < 2048; it += NGW) { int lane_ = fresh_lane(); ssm_item<false>(p, lds + wave * 16384, it, lane_); }
#endif
#if P2S & 8
    { int it = gw; for (; it + NGW < 4096; it += 2 * NGW) { int lane_ = fresh_lane(); ssm_sample_items<2>(p, lds + wave * 16384, it, NGW, lane_); }
      if (it < 4096) { int lane_ = fresh_lane(); ssm_sample_items<1>(p, lds + wave * 16384, it, NGW, lane_); } }
#endif
    GRID_BAR();

#endif
#if PH & (1<<3)
    for (int rep_ = 0; rep_ < 1 + ((DUP >> 3) & 1); ++rep_) {
    for (int it = gw; it < 2048; it += NGW) { int lane_ = fresh_lane(); ssm_item<true>(p, lds + wave * 16384, it, lane_); }
    GRID_BAR();

    }
#endif
#if PH & (1<<4)
    for (int rep_ = 0; rep_ < 1 + ((DUP >> 4) & 1); ++rep_) {
    {
        const bool g256 = (G == 256);
        pg8::Gemm g{(const bf16*)(ws + WS_Z), (const bf16*)(ws + WS_WGLU), MPROMPT, 512, 512}; pg8::StaticOrder S; S.init(MPROMPT, 512, G, bx);
        EpiGlu E{(const bf16*)(ws + WS_Z), (bf16*)(ws + WS_AS), p.in[I_BGLU]};
        pg8::Gemm g2{(const bf16*)(ws + WS_XB), (const bf16*)(ws + WS_WIN) + (size_t)3072 * D, MPROMPT, 256, D}; pg8::StaticOrder S2;
        if (g256) S2.init(MPROMPT, 256, 64, (bx >= 128 && bx < 192) ? bx - 128 : (1 << 20)); else S2.init(MPROMPT, 256, G, bx);
        EpiIn E2{ws, p.in[I_BG], 24};
        const int lo4 = g256 ? 192 : 0;
        { int lane_ = fresh_lane(); skinny_gemm<EpiGlu, 512, 1>(lds, g.A, g.Bt, 512, E, bx, G, wave, lane_, lo4); }
        { int lane_ = fresh_lane(); skinny_gemm<EpiIn, 1024, 1>(lds, g2.A, g2.Bt, 256, E2, bx, G, wave, lane_, lo4); }
        pg8::gemm_phase<EpiGlu, pg8::StaticOrder, true, true>(ldsg, g, S, E, wave, wave * 64 + fresh_lane());
        pg8::gemm_phase<EpiIn, pg8::StaticOrder, true, true>(ldsg, g2, S2, E2, wave, wave * 64 + fresh_lane());
        {
            constexpr int W0 = P0_I0 + 8 * 16, WSPLIT = W0 + 2560;
            const int lane_ = fresh_lane();
            if (!g256) p0_weights(p, lds, W0, P0_NITEMS, gw, NGW, wave, lane_);
            else if (bx < 128) p0_weights(p, lds, W0, WSPLIT, bx * NWAVES + wave, 128 * NWAVES, wave, lane_);
            else if (bx >= 192) p0_weights(p, lds, WSPLIT, P0_NITEMS, (bx - 192) * NWAVES + wave, 64 * NWAVES, wave, lane_);
        }
    }
    GRID_BAR();

    }
#endif
#if PH & (1<<5)
    for (int rep_ = 0; rep_ < 1 + ((DUP >> 5) & 1); ++rep_) {
    {
        pg8::Gemm g{(const bf16*)(ws + WS_AS), (const bf16*)(ws + WS_WBA), MPROMPT, D, D}; pg8::StaticOrder S; S.init(MPROMPT, D, G, bx);
        EpiMerge E{(const bf16*)(ws + WS_G), (bf16*)(ws + WS_M)};
        { int lane_ = fresh_lane(); skinny_gemm<EpiMerge, 1024, 4>(lds, g.A, g.Bt, D, E, bx, G, wave, lane_, 0); }
        pg8::gemm_phase<EpiMerge, pg8::StaticOrder, true, true>(ldsg, g, S, E, wave, wave * 64 + fresh_lane());
    }
    GRID_BAR();

    }
#endif
#if PH & (1<<6)
    for (int rep_ = 0; rep_ < 1 + ((DUP >> 6) & 1); ++rep_) {
    {
        pg8::Gemm g{(const bf16*)(ws + WS_M), (const bf16*)(ws + WS_WOUT), MPROMPT, D, D}; pg8::StaticOrder S; S.init(MPROMPT, D, G, bx);
        EpiRes<0> E{p.in[I_XP], p.in[I_XS], p.out, (bf16*)(ws + WS_XB), (float*)(ws + WS_SS1)};
#if XPROBE & 8
        { EpiRes<0> E2{p.in[I_XP], p.in[I_XS], (float*)(ws + WS_ACT), (bf16*)(ws + WS_XB), (float*)(ws + WS_E)};
          pg8::gemm_phase<EpiRes<0>, pg8::StaticOrder, true, true>(ldsg, g, S, E2, wave, wave * 64 + fresh_lane()); }
#endif
        { int lane_ = fresh_lane(); skinny_gemm<EpiRes<0>, 1024, 4>(lds, g.A, g.Bt, D, E, bx, G, wave, lane_, 0); }
        pg8::gemm_phase<EpiRes<0>, pg8::StaticOrder, true, true>(ldsg, g, S, E, wave, wave * 64 + fresh_lane());
    }
    GRID_BAR();

    }
#endif
#if PH & (1<<7)
    for (int rep_ = 0; rep_ < 1 + ((DUP >> 7) & 1); ++rep_) {
    {
        pg8::Gemm g{(const bf16*)(ws + WS_XB), (const bf16*)(ws + WS_WGU), MPROMPT, NGU, D}; pg8::StaticOrder S; S.init(MPROMPT, NGU, G, bx);
        EpiFfnUp E{(const float*)(ws + WS_SS1), (bf16*)(ws + WS_ACT)};
        { int lane_ = fresh_lane(); skinny_gemm<EpiFfnUp, 1024, 1>(lds, g.A, g.Bt, NGU, E, bx, G, wave, lane_, (G == 256) ? 128 : 0); }
        pg8::gemm_phase<EpiFfnUp, pg8::StaticOrder, true, true>(ldsg, g, S, E, wave, wave * 64 + fresh_lane());
    }
    GRID_BAR();

    }
#endif
#if PH & (1<<8)
    {
        pg8::Gemm g{(const bf16*)(ws + WS_ACT), (const bf16*)(ws + WS_WD), MPROMPT, D, FF}; pg8::StaticOrder S; S.init(MPROMPT, D, G, bx);
        EpiRes<1> E{p.in[I_XP], p.in[I_XS], p.out, (bf16*)(ws + WS_XB), (float*)(ws + WS_SS2)};
        unsigned* cnt = (unsigned*)(ws + WS_CNT);
        const f32x4* g4 = (const f32x4*)p.in[I_NFG]; const float* ss2 = (const float*)(ws + WS_SS2);
        { int lane_ = fresh_lane(); skinny_gemm<EpiRes<1>, 2816, 4>(lds, g.A, g.Bt, D, E, bx, G, wave, lane_, 0); }
        int m0 = 0, m1 = 0, mstep = 2;
        if (G == 256) {
            asm volatile("s_waitcnt vmcnt(0)" ::: "memory"); __syncthreads();
            if (wave == 0 && fresh_lane() == 0) { __builtin_amdgcn_fence(__ATOMIC_RELEASE, "agent"); asm volatile("s_waitcnt vmcnt(0)" ::: "memory");
                __hip_atomic_fetch_add(cnt, 1u, __ATOMIC_RELAXED, __HIP_MEMORY_SCOPE_AGENT); }
            EpiFinal EF{(const bf16*)(ws + WS_XB), p.out, (float*)(ws + WS_SS2), p.in[I_NFG], cnt};
            pg8::gemm_phase<EpiFinal, pg8::StaticOrder, false, true>(ldsg, g, S, EF, wave, wave * 64 + fresh_lane());
            if (bx < 64) {
                if (wave == 0 && fresh_lane() == 0) { unsigned sp = 0; while (__hip_atomic_load(cnt, __ATOMIC_RELAXED, __HIP_MEMORY_SCOPE_AGENT) < (unsigned)G && ++sp < (1u << 22)) __builtin_amdgcn_s_sleep(2);
                    __builtin_amdgcn_fence(__ATOMIC_ACQUIRE, "agent"); asm volatile("s_waitcnt vmcnt(0)" ::: "memory"); }
                __syncthreads();
                if (wave == 0) { m0 = MPROMPT + 2 * bx; m1 = m0 + 2; }
            }
        } else {
            pg8::gemm_phase<EpiRes<1>, pg8::StaticOrder, true, true>(ldsg, g, S, E, wave, wave * 64 + fresh_lane());
            GRID_BAR();
            m0 = 2 * gw; m1 = MR; mstep = 2 * NGW;
        }
        const int lane = fresh_lane();
        for (int mm = m0; mm < m1; mm += mstep) {
            f32x4 v[2][4]; float rs[2];
#pragma unroll
            for (int r = 0; r < 2; ++r) { rs[r] = ss2[mm + r]; const bf16* xr = (const bf16*)(ws + WS_XB) + (size_t)(mm + r) * D + 4 * lane;
#pragma unroll
                for (int j = 0; j < 4; ++j) v[r][j] = ld_bf4(xr + 256 * j); }
#pragma unroll
            for (int r = 0; r < 2; ++r) { const float rstd = 1.f / sqrtf(rs[r] * (1.f / D) + EPS); f32x4* yr = (f32x4*)(p.out + (size_t)(mm + r) * D) + lane;
#pragma unroll
                for (int j = 0; j < 4; ++j) yr[64 * j] = v[r][j] * rstd * g4[lane + 64 * j]; }
        }
    }
#endif
}

#undef GRID_BAR
extern "C" void kernel_launch(void* const* d_in, const int* in_sizes, int n_in, void* d_out, int out_size, void* d_ws, size_t ws_size, hipStream_t stream) {
    static int grid = 0;
    if (grid == 0) {
        if (n_in != 28 || ws_size < WS_END) { fprintf(stderr, "kernel_launch: unexpected n_in %d / ws_size %zu\n", n_in, ws_size); grid = -1; return; }
        int dev = 0, cus = 0, per_cu = 0;
        hipGetDevice(&dev); hipDeviceGetAttribute(&cus, hipDeviceAttributeMultiprocessorCount, dev);
        if (hipFuncSetAttribute((const void*)mk_fwd, hipFuncAttributeMaxDynamicSharedMemorySize, LDS_BYTES) != hipSuccess) { fprintf(stderr, "kernel_launch: hipFuncSetAttribute failed\n"); grid = -1; return; }
        if (hipOccupancyMaxActiveBlocksPerMultiprocessor(&per_cu, (const void*)mk_fwd, NTHREADS, LDS_BYTES) != hipSuccess || per_cu < 1) { fprintf(stderr, "kernel_launch: occupancy query says %d\n", per_cu); per_cu = 1; }
        (void)hipGetLastError();
        grid = cus * 1;
        fprintf(stderr, "kernel_launch: cus %d per_cu %d grid %d\n", cus, per_cu, grid);
    }
    if (grid < 0) return;
    if (hipMemsetAsync(d_ws, 0, WS_ZERO_BYTES, stream) != hipSuccess) { fprintf(stderr, "kernel_launch: memset failed\n"); return; }
    Params prm{};
    for (int i = 0; i < 28; ++i) prm.in[i] = (const float*)d_in[i];
    prm.out = (float*)d_out; prm.ws = (unsigned char*)d_ws;
    void* args[] = {&prm};
    hipError_t e = hipLaunchCooperativeKernel((const void*)mk_fwd, dim3(grid), dim3(NTHREADS), args, LDS_BYTES, stream);
    if (e != hipSuccess) fprintf(stderr, "cooperative launch failed: %s (grid %d)\n", hipGetErrorString(e), grid);
}
```

```cpp
#include <hip/hip_runtime.h>
#include <hip/hip_cooperative_groups.h>
#include <cstdio>
#include <cstdint>
namespace cg = cooperative_groups;
namespace pg8 {
#define PG8_LAS __attribute__((address_space(3)))
typedef unsigned short bf16_t;
typedef short bf16x8 __attribute__((ext_vector_type(8)));
typedef float f32x4 __attribute__((ext_vector_type(4)));
typedef unsigned u32x4 __attribute__((ext_vector_type(4)));
constexpr int BM = 256, BK = 64, HALF = 128, HTB = HALF * BK * 2  , STAGE_BYTES = 8 * HTB, NXCD = 8, WGM = 8;

__host__ __device__ __forceinline__ int lds_byte(int r, int c) { const int st = (r >> 4) * 2 + (c >> 5), rr = r & 15, cc = c & 31, ob = rr * 64 + cc * 2; return st * 1024 + (ob ^ (((ob >> 9) & 1) << 5)); }
__host__ __device__ __forceinline__ void stage_rc(int b, int& R, int& C) { const int st = b / 1024, sb = b % 1024, swz = sb ^ (((sb >> 9) & 1) << 5); R = (st >> 1) * 16 + swz / 64; C = (st & 1) * 32 + (swz % 64) / 2; }
__host__ __device__ __forceinline__ int perm32(int rho) { const int n = rho >> 4, i = rho & 15; return 8 * (i >> 2) + 4 * n + (i & 3); }

struct Unit { int pm, pn; };
struct Gemm { const bf16_t* A; const bf16_t* Bt; int M, N, K; };

struct StaticOrder {
    int nM, nN, nwg, G, c;
    __host__ __device__ void init(int M, int N, int G_, int c_) { nM = M / BM; nN = N / BM; nwg = nM * nN; G = G_; c = c_; }
    __host__ __device__ bool next(int i, Unit& u) const {
        const long L = (long)i * G + c; if (L >= nwg) return false;
        int wgid = (int)L; { const int q = nwg / NXCD, r = nwg % NXCD, xcd = wgid % NXCD, off = wgid / NXCD; wgid = (xcd < r ? xcd * (q + 1) : r * (q + 1) + (xcd - r) * q) + off; }
        const int nig = WGM * nN, gid = wgid / nig, fm = gid * WGM, gsz = (nM - fm) < WGM ? (nM - fm) : WGM;
        u.pm = fm + ((wgid % nig) % gsz); u.pn = (wgid % nig) / gsz; return true;
    }
    __device__ __forceinline__ void a_ready(const Unit&) const {}
    __device__ __forceinline__ void done(const Unit&) const {}
};
template <class Epi, class Sched, bool ALIGN_EPI = false, bool SP2 = false>
__device__ __forceinline__ void gemm_phase(PG8_LAS unsigned char* lds, const Gemm g, const Sched& S, const Epi& E, const int wid, int tid) {
    asm volatile("" : "+v"(tid));
    const int lane = tid & 63, wr = wid >> 2, wc = wid & 3, fr = lane & 15, fq = lane >> 4;
    const int K = g.K, nt = K / BK;
    unsigned voffA[2], voffB[2];
#pragma unroll
    for (int i = 0; i < 2; ++i) { int R, C; stage_rc(tid * 16 + i * 8192, R, C); const int Rb = Epi::PERM ? ((R & ~31) + perm32(R & 31)) : R;
        voffA[i] = (unsigned)(R * K + C) * 2u; voffB[i] = (unsigned)(Rb * K + C) * 2u; }
    const size_t kstep = (size_t)(BK * 2);
    const size_t hstep = (size_t)HALF * K * 2;
    const size_t tstep = 2 * hstep;
    const unsigned ldsw = (unsigned)wid * 1024u;
    const int aoff = lds_byte(wr * 64 + fr, fq * 8), boff = lds_byte(wc * 32 + fr, fq * 8);
#define PG8_SA(b, h) (((b) * 2 + (h)) * HTB)
#define PG8_SB(b, h) ((4 + (b) * 2 + (h)) * HTB)
#define PG8_STAGE(bufoff, gbase, voff) do { _Pragma("unroll") for (int _i = 0; _i < 2; ++_i) \
        __builtin_amdgcn_global_load_lds((const unsigned*)((const char*)(gbase) + (voff)[_i]), (PG8_LAS unsigned*)(lds + (bufoff) + ldsw + _i * 8192), 16, 0, 0); } while (0)
#define PG8_LDA(dst, b, h) do { _Pragma("unroll") for (int m = 0; m < 4; ++m) _Pragma("unroll") for (int k = 0; k < 2; ++k) dst[m][k] = *(const PG8_LAS bf16x8*)(lds + PG8_SA(b, h) + aoff + m * 2048 + k * 1024); } while (0)
#define PG8_LDB(dst, b, h) do { _Pragma("unroll") for (int n = 0; n < 2; ++n) _Pragma("unroll") for (int k = 0; k < 2; ++k) dst[n][k] = *(const PG8_LAS bf16x8*)(lds + PG8_SB(b, h) + boff + n * 2048 + k * 1024); } while (0)
#define PG8_MMA(ai, bj, At, Bt) do { __builtin_amdgcn_s_setprio(1); _Pragma("unroll") for (int m = 0; m < 4; ++m) _Pragma("unroll") for (int n = 0; n < 2; ++n) _Pragma("unroll") for (int k = 0; k < 2; ++k) \
        acc[ai][bj][m][n] = __builtin_amdgcn_mfma_f32_16x16x32_bf16(Bt[n][k], At[m][k], acc[ai][bj][m][n], 0, 0, 0); __builtin_amdgcn_s_setprio(0); } while (0)
#define PG8_WAIT_V(n) asm volatile("s_waitcnt vmcnt(" #n ")" ::: "memory")
#define PG8_WAIT_L(n) asm volatile("s_waitcnt lgkmcnt(" #n ")" ::: "memory")
#define PG8_BAR __builtin_amdgcn_s_barrier()
#define PG8_SCHED __builtin_amdgcn_sched_barrier(0)
    Unit cur, nxt; int ui = 0;
    if (!S.next(0, cur)) return;
    f32x4 acc[2][2][4][2];
#pragma unroll
    for (int a = 0; a < 2; ++a)
#pragma unroll
        for (int b = 0; b < 2; ++b)
#pragma unroll
            for (int m = 0; m < 4; ++m)
#pragma unroll
                for (int n = 0; n < 2; ++n) acc[a][b][m][n] = (f32x4){0.f, 0.f, 0.f, 0.f};
    bf16x8 At[4][2], B0[2][2], B1[2][2];
    const char* cA = (const char*)g.A + (size_t)cur.pm * tstep; const char* cB = (const char*)g.Bt + (size_t)cur.pn * tstep;
    S.a_ready(cur);
    if constexpr (SP2) {
        PG8_STAGE(PG8_SB(0, 0), cB, voffB); PG8_STAGE(PG8_SB(0, 1), cB + hstep, voffB); PG8_STAGE(PG8_SA(0, 0), cA, voffA); PG8_STAGE(PG8_SA(0, 1), cA + hstep, voffA);
        if (wr == 1) PG8_BAR;
        PG8_WAIT_V(2); PG8_BAR;
        PG8_STAGE(PG8_SB(1, 0), cB + kstep, voffB); PG8_STAGE(PG8_SA(1, 0), cA + kstep, voffA); PG8_STAGE(PG8_SB(1, 1), cB + hstep + kstep, voffB);
        PG8_WAIT_V(6); PG8_BAR;
    } else {
        PG8_STAGE(PG8_SB(0, 0), cB, voffB); PG8_STAGE(PG8_SA(0, 0), cA, voffA); PG8_STAGE(PG8_SB(0, 1), cB + hstep, voffB); PG8_STAGE(PG8_SA(0, 1), cA + hstep, voffA);
        if (wr == 1) PG8_BAR;
        PG8_WAIT_V(4); PG8_BAR;
        PG8_STAGE(PG8_SB(1, 0), cB + kstep, voffB); PG8_STAGE(PG8_SA(1, 0), cA + kstep, voffA); PG8_STAGE(PG8_SB(1, 1), cB + hstep + kstep, voffB);
        PG8_WAIT_V(6); PG8_BAR;
    }
    for (;;) {
        const bool has_next = S.next(ui + 1, nxt);
        const char* nA = has_next ? (const char*)g.A + (size_t)nxt.pm * tstep : cA; const char* nB = has_next ? (const char*)g.Bt + (size_t)nxt.pn * tstep : cB;
        for (int t = 0; t < nt; t += 2) {
            const bool last = (t == nt - 2);
            const char* a1 = cA + (size_t)(t + 1) * kstep;
            const char* a2 = last ? nA : cA + (size_t)(t + 2) * kstep; const char* b2 = last ? nB : cB + (size_t)(t + 2) * kstep;
            const char* a3 = a2 + kstep; const char* b3 = b2 + kstep;
            if (last && has_next) S.a_ready(nxt);
            if constexpr (Epi::HAS_MID) { if (t == (nt >> 1)) E.mid(acc, cur, wr, wc, fr, fq); }
            if constexpr (SP2) {
            PG8_LDB(B0, 0, 0); PG8_LDB(B1, 0, 1); PG8_SCHED; PG8_LDA(At, 0, 0); PG8_STAGE(PG8_SA(1, 1), a1 + hstep, voffA);
            PG8_WAIT_V(8); PG8_WAIT_L(0); PG8_BAR; PG8_MMA(0, 0, At, B0); PG8_MMA(0, 1, At, B1); PG8_BAR; PG8_SCHED;
            PG8_LDA(At, 0, 1); PG8_STAGE(PG8_SB(0, 0), b2, voffB); PG8_STAGE(PG8_SB(0, 1), b2 + hstep, voffB); PG8_STAGE(PG8_SA(0, 0), a2, voffA);
            PG8_WAIT_V(8); PG8_WAIT_L(0); PG8_BAR; PG8_MMA(1, 0, At, B0); PG8_MMA(1, 1, At, B1); PG8_BAR; PG8_SCHED;
            PG8_LDB(B0, 1, 0); PG8_LDB(B1, 1, 1); PG8_SCHED; PG8_LDA(At, 1, 0); PG8_STAGE(PG8_SA(0, 1), a2 + hstep, voffA);
            PG8_WAIT_V(8); PG8_WAIT_L(0); PG8_BAR; PG8_MMA(0, 0, At, B0); PG8_MMA(0, 1, At, B1); PG8_BAR; PG8_SCHED;
            PG8_LDA(At, 1, 1); PG8_STAGE(PG8_SB(1, 0), b3, voffB); PG8_STAGE(PG8_SB(1, 1), b3 + hstep, voffB); PG8_STAGE(PG8_SA(1, 0), a3, voffA);
            PG8_WAIT_V(8); PG8_WAIT_L(0); PG8_BAR; PG8_MMA(1, 0, At, B0); PG8_MMA(1, 1, At, B1); PG8_BAR; PG8_SCHED;
            } else {
            PG8_LDB(B0, 0, 0); PG8_SCHED; PG8_LDA(At, 0, 0); PG8_STAGE(PG8_SA(1, 1), a1 + hstep, voffA);
            PG8_WAIT_L(8); PG8_BAR; PG8_WAIT_L(0); PG8_MMA(0, 0, At, B0); PG8_BAR; PG8_SCHED;
            PG8_LDB(B1, 0, 1); PG8_STAGE(PG8_SB(0, 0), b2, voffB);
            PG8_BAR; PG8_WAIT_L(0); PG8_MMA(0, 1, At, B1); PG8_BAR;
            PG8_LDA(At, 0, 1); PG8_STAGE(PG8_SA(0, 0), a2, voffA);
            PG8_BAR; PG8_WAIT_L(0); PG8_MMA(1, 0, At, B0); PG8_BAR; PG8_SCHED;
            PG8_STAGE(PG8_SB(0, 1), b2 + hstep, voffB);
            PG8_WAIT_V(6); PG8_BAR; PG8_MMA(1, 1, At, B1); PG8_BAR;
            PG8_LDB(B0, 1, 0); PG8_SCHED; PG8_LDA(At, 1, 0); PG8_STAGE(PG8_SA(0, 1), a2 + hstep, voffA);
            PG8_WAIT_L(8); PG8_BAR; PG8_WAIT_L(0); PG8_MMA(0, 0, At, B0); PG8_BAR; PG8_SCHED;
            PG8_LDB(B1, 1, 1); PG8_STAGE(PG8_SB(1, 0), b3, voffB);
            PG8_BAR; PG8_WAIT_L(0); PG8_MMA(0, 1, At, B1); PG8_BAR;
            PG8_LDA(At, 1, 1); PG8_STAGE(PG8_SA(1, 0), a3, voffA);
            PG8_BAR; PG8_WAIT_L(0); PG8_MMA(1, 0, At, B0); PG8_BAR; PG8_SCHED;
            PG8_STAGE(PG8_SB(1, 1), b3 + hstep, voffB);
            PG8_WAIT_V(6); PG8_BAR; PG8_MMA(1, 1, At, B1); PG8_BAR;
            }
        }
        if constexpr (ALIGN_EPI) { if (wr == 0) PG8_BAR; }
        if constexpr (!Epi::AFTER_DRAIN) { E(acc, cur, wr, wc, fr, fq); S.done(cur); }
        if (!has_next) break;
#pragma unroll
        for (int a = 0; a < 2; ++a)
#pragma unroll
            for (int b = 0; b < 2; ++b)
#pragma unroll
                for (int m = 0; m < 4; ++m)
#pragma unroll
                    for (int n = 0; n < 2; ++n) acc[a][b][m][n] = (f32x4){0.f, 0.f, 0.f, 0.f};
        cur = nxt; cA = nA; cB = nB; ++ui;
        if constexpr (ALIGN_EPI) { if (wr == 1) PG8_BAR; }
    }
    PG8_WAIT_V(0);
    if constexpr (!ALIGN_EPI) { if (wr == 0) PG8_BAR; }
    PG8_BAR;
    if constexpr (Epi::AFTER_DRAIN) { E.fused(acc, cur, wr, wc, fr, fq, lds, wid, lane); S.done(cur); }
#undef PG8_SA
#undef PG8_SB
#undef PG8_STAGE
#undef PG8_LDA
#undef PG8_LDB
#undef PG8_MMA
#undef PG8_WAIT_V
#undef PG8_WAIT_L
#undef PG8_BAR
#undef PG8_SCHED
}
}

#define LAS __attribute__((address_space(3)))
typedef unsigned short bf16;
typedef float f32x4 __attribute__((ext_vector_type(4)));
typedef float f32x2 __attribute__((ext_vector_type(2)));
typedef short bf16x8 __attribute__((ext_vector_type(8)));
typedef short bf16x4 __attribute__((ext_vector_type(4)));
typedef unsigned u32x4 __attribute__((ext_vector_type(4)));
typedef unsigned u32x2 __attribute__((ext_vector_type(2)));

constexpr int D = 1024, TPR = 4096, MPROMPT = 16384, NSAMP = 128, MR = 16512, MP = 16640;
constexpr int INW = 3328, FF = 2816, NGU = 5632;
constexpr float EPS = 1e-5f;
constexpr int NSEG = 16;
constexpr int NWAVES = 8, NTHREADS = 512;
constexpr int LDS_BYTES = 135168;

constexpr size_t O_Y = 0, O_KWP = 16908288, O_VWP = 16973824, O_SRP = 17039360, O_SIP = 17047552,
                 O_KWS = 17055744, O_VWS = 19152896, O_SRS = 21250048, O_SIS = 21512192;

constexpr size_t MiB = 1u << 20;
constexpr size_t WS_BAR = 96 * 1024, WS_CNT = 112 * 1024, WS_ZERO_BYTES = 256 * 1024;
constexpr size_t WS_SS1 = 0, WS_SS2 = 128 * 1024, WS_ROPE = 256 * 1024, WS_LBAR = 640 * 1024, WS_LBARS = 656 * 1024,
                 WS_BBM = 672 * 1024, WS_CCM = 800 * 1024, WS_BBF = 1024 * 1024;
constexpr size_t WS_WIN = 2 * MiB, WS_WGLU = 17 * MiB / 2, WS_WBA = 9 * MiB, WS_WBS = 10 * MiB, WS_WOUT = 11 * MiB, WS_WGU = 13 * MiB, WS_WD = 24 * MiB;
constexpr size_t WS_XB = 30 * MiB;
constexpr size_t WS_Q = 63 * MiB;
constexpr size_t WS_K = 80 * MiB, WS_V = 85 * MiB;
constexpr size_t WS_U = 90 * MiB;
constexpr size_t WS_G = 107 * MiB;
constexpr size_t WS_Z = 172 * MiB;
constexpr size_t WS_M = 189 * MiB;
constexpr size_t WS_E = 222 * MiB;
constexpr size_t WS_ACT = 63 * MiB;
constexpr size_t WS_AS = 223 * MiB;
constexpr size_t WS_END = 256 * MiB;
static_assert(WS_AS + (size_t)MP * D * 2 <= WS_END, "AS map");
static_assert(WS_ACT + (size_t)MP * FF * 2 <= WS_Z, "act overlay");
static_assert(WS_WIN + (size_t)INW * D * 2 <= WS_WGLU && WS_WGU + (size_t)NGU * D * 2 <= WS_WD && WS_WD + (size_t)D * FF * 2 <= WS_XB, "weights map");
static_assert(WS_XB + (size_t)MP * D * 2 <= WS_Q && WS_Q + (size_t)MP * 512 * 2 <= WS_K && WS_G + (size_t)MP * 2048 * 2 <= WS_Z && WS_M + (size_t)MP * D * 2 <= WS_E, "act map");

struct Params { const float* in[28]; float* out; unsigned char* ws; };

enum { I_XP = 0, I_XS, I_SK, I_SV, I_SRE, I_SIM, I_N1G, I_WIN, I_BG, I_SINK, I_LRE, I_LIM, I_LDT, I_BRE, I_BIM, I_CRE, I_CIM, I_SD, I_WGLU, I_BGLU,
       I_WBA, I_WBS, I_WOUT, I_N2G, I_WFG, I_WFU, I_WFD, I_NFG };

#define LDS_WAIT() asm volatile("s_waitcnt lgkmcnt(0)" ::: "memory")
__device__ __forceinline__ unsigned f2bf(float f) { unsigned u = __builtin_bit_cast(unsigned, f); return (u + 0x7fffu + ((u >> 16) & 1u)) >> 16; }
__device__ __forceinline__ unsigned pk2(float lo, float hi) { unsigned r; asm("v_cvt_pk_bf16_f32 %0, %1, %2" : "=v"(r) : "v"(lo), "v"(hi)); return r; }
__device__ __forceinline__ float bflo(unsigned w) { return __builtin_bit_cast(float, w << 16); }
__device__ __forceinline__ float bfhi(unsigned w) { return __builtin_bit_cast(float, w & 0xffff0000u); }
__device__ __forceinline__ float bf2f(unsigned short b) { return __builtin_bit_cast(float, (unsigned)b << 16); }
__device__ __forceinline__ f32x4 ld_bf4(const bf16* p) { const u32x2 w = *(const u32x2*)p; return (f32x4){bflo(w.x), bfhi(w.x), bflo(w.y), bfhi(w.y)}; }
__device__ __forceinline__ void st_bf4(bf16* p, f32x4 v) { u32x2 w; w.x = pk2(v[0], v[1]); w.y = pk2(v[2], v[3]); *(u32x2*)p = w; }
__device__ __forceinline__ void ld_bf8(const bf16* p, f32x4& a, f32x4& b) { const u32x4 w = *(const u32x4*)p; a = (f32x4){bflo(w.x), bfhi(w.x), bflo(w.y), bfhi(w.y)}; b = (f32x4){bflo(w.z), bfhi(w.z), bflo(w.w), bfhi(w.w)}; }
__device__ __forceinline__ void st_bf8(bf16* p, f32x4 a, f32x4 b) { u32x4 w; w.x = pk2(a[0], a[1]); w.y = pk2(a[2], a[3]); w.z = pk2(b[0], b[1]); w.w = pk2(b[2], b[3]); *(u32x4*)p = w; }
__device__ __forceinline__ float sigm(float x) { return __builtin_amdgcn_rcpf(1.f + __expf(-x)); }
__device__ __forceinline__ float gelu_tanh(float x) { const float t = 1.5957691216057308f * (x + 0.044715f * x * x * x); return x * __builtin_amdgcn_rcpf(1.f + __expf(-t)); }
__device__ __forceinline__ float wave_sum(float v) {
#pragma unroll
    for (int o = 1; o < 64; o <<= 1) v += __shfl_xor(v, o);
    return v;
}
__device__ __forceinline__ float wave_max(float v) {
#pragma unroll
    for (int o = 1; o < 64; o <<= 1) v = fmaxf(v, __shfl_xor(v, o));
    return v;
}

__device__ __forceinline__ int fresh_lane() { int l = (int)__builtin_amdgcn_mbcnt_hi(~0u, __builtin_amdgcn_mbcnt_lo(~0u, 0u)); asm volatile("" : "+v"(l)); return l; }

__device__ __forceinline__ void p0_transpose_item(const float* W, int K, int N, bf16* WT, int mode, const float* gk, float* scr, int item, int lane, int ldk = 0, int koff = 0) {
    if (ldk == 0) ldk = K;
    const int nblk = N / 32, kb = item / nblk, nb = item % nblk, k0 = 64 * kb, n0 = 32 * nb;
    float tv[32];
#pragma unroll
    for (int i = 0; i < 32; ++i) { const int kk = 2 * i + (lane >> 5); tv[i] = W[(size_t)(k0 + kk) * N + n0 + (lane & 31)]; }
    if (gk) {
#pragma unroll
        for (int i = 0; i < 32; ++i) tv[i] *= gk[k0 + 2 * i + (lane >> 5)];
    }
#pragma unroll
    for (int i = 0; i < 32; ++i) scr[(2 * i + (lane >> 5)) * 33 + (lane & 31)] = tv[i];
    LDS_WAIT();
    const int c = lane & 7;
#pragma unroll
    for (int j = 0; j < 4; ++j) { const int n = (lane >> 3) + 8 * j; const float* s = scr + (8 * c) * 33 + n;
        u32x4 o; o.x = pk2(s[0 * 33], s[1 * 33]); o.y = pk2(s[2 * 33], s[3 * 33]); o.z = pk2(s[4 * 33], s[5 * 33]); o.w = pk2(s[6 * 33], s[7 * 33]);
        const int nn = n0 + n; const int row = (mode == 0) ? nn : (((nn >> 7) << 8) + (mode == 2 ? 128 : 0) + (nn & 127));
        *(u32x4*)(WT + (size_t)row * ldk + koff + k0 + 8 * c) = o; }
    LDS_WAIT();
}

constexpr int P0_I0 = 16 * 104, P0_NITEMS = 16 * 104 + 8 * 16 + 8 * 32 + 8 * 32 + 16 * 32 + 16 * 88 + 16 * 88 + 44 * 32;
__device__ __forceinline__ void p0_weights(const Params& p, unsigned char* lds, int it0, int it1, int gw, int NGW, int wave, int lane) {
    unsigned char* ws = p.ws;
    float* scr = (float*)(lds + wave * 16384);
    constexpr int I0 = 16 * 104, I1 = 8 * 16, I2 = 8 * 32, I3 = 8 * 32, I4 = 16 * 32, I5 = 16 * 88, I6 = 16 * 88;
    for (int it = it0 + gw; it < it1; it += NGW) {
        int r = it;
        if (r < I0) { p0_transpose_item(p.in[I_WIN], 1024, INW, (bf16*)(ws + WS_WIN), 0, nullptr, scr, r, lane); continue; } r -= I0;
        if (r < I1) { p0_transpose_item(p.in[I_WGLU], 512, 512, (bf16*)(ws + WS_WGLU), 0, nullptr, scr, r, lane); continue; } r -= I1;
        if (r < I2) { p0_transpose_item(p.in[I_WBA], 512, 1024, (bf16*)(ws + WS_WBA), 0, nullptr, scr, r, lane, 1024, 0); continue; } r -= I2;
        if (r < I3) { p0_transpose_item(p.in[I_WBS], 512, 1024, (bf16*)(ws + WS_WBA), 0, nullptr, scr, r, lane, 1024, 512); continue; } r -= I3;
        if (r < I4) { p0_transpose_item(p.in[I_WOUT], 1024, 1024, (bf16*)(ws + WS_WOUT), 0, nullptr, scr, r, lane); continue; } r -= I4;
        if (r < I5) { p0_transpose_item(p.in[I_WFG], 1024, FF, (bf16*)(ws + WS_WGU), 1, p.in[I_N2G], scr, r, lane); continue; } r -= I5;
        if (r < I6) { p0_transpose_item(p.in[I_WFU], 1024, FF, (bf16*)(ws + WS_WGU), 2, p.in[I_N2G], scr, r, lane); continue; } r -= I6;
        p0_transpose_item(p.in[I_WFD], FF, 1024, (bf16*)(ws + WS_WD), 0, nullptr, scr, r, lane);
    }
}

__device__ __forceinline__ void p0_prologue(const Params& p, unsigned char* lds, int gw, int NGW, int wave, int lane) {
    unsigned char* ws = p.ws;
    bf16* xb = (bf16*)(ws + WS_XB);
    const f32x4* g4 = (const f32x4*)p.in[I_N1G];
    for (int m0 = 2 * gw; m0 < MR; m0 += 2 * NGW) {
        f32x4 v[2][4]; float s[2] = {0.f, 0.f};
#pragma unroll
        for (int r = 0; r < 2; ++r) {
            const int m = m0 + r;
            const float* xrow = (m < MPROMPT) ? p.in[I_XP] + (size_t)m * D : p.in[I_XS] + (size_t)(m - MPROMPT) * D;
            const f32x4* xr = (const f32x4*)xrow + 2 * lane;
#pragma unroll
            for (int j = 0; j < 2; ++j) { v[r][2 * j] = xr[128 * j]; v[r][2 * j + 1] = xr[128 * j + 1]; }
        }
#pragma unroll
        for (int r = 0; r < 2; ++r) {
#pragma unroll
            for (int j = 0; j < 4; ++j) s[r] += (v[r][j].x * v[r][j].x + v[r][j].y * v[r][j].y) + (v[r][j].z * v[r][j].z + v[r][j].w * v[r][j].w);
        }
#pragma unroll
        for (int r = 0; r < 2; ++r) {
            const int m = m0 + r;
            const float rstd = 1.f / sqrtf(wave_sum(s[r]) * (1.f / D) + EPS);
#pragma unroll
            for (int j = 0; j < 2; ++j) { const f32x4 ga = g4[2 * lane + 128 * j], gb = g4[2 * lane + 128 * j + 1];
                st_bf8(xb + (size_t)m * D + 8 * lane + 512 * j, v[r][2 * j] * rstd * ga, v[r][2 * j + 1] * rstd * gb); }
        }
    }
    const int gt = gw * 64 + lane, NGT = NGW * 64;
    for (int i = gt; i < 4097 * 8; i += NGT) {
        const int pi = i >> 3, fi = i & 7; const double pos = (pi == 4096) ? 8192.0 : (double)pi;
        const double invf[8] = {1.0, 0.19392274474868576, 0.03760603093086393, 0.007292664737217109, 0.001414213562373095, 0.0002742481756762073, 5.318295896944988e-05, 1.031338537721246e-05};
        double fsel = invf[0];
#pragma unroll
        for (int q = 1; q < 8; ++q) fsel = (fi == q) ? invf[q] : fsel;
        const double rev = pos * fsel * 0.15915494309189535; const double fr = rev - __builtin_rint(rev);
        const float a = (float)(fr * 6.283185307179586);
        ((f32x2*)(ws + WS_ROPE))[i] = (f32x2){cosf(a), sinf(a)};
    }
    for (int i = gw; i < 32 * 64; i += NGW) {
        const int g = i >> 6, pp = i & 63;
        const double dt = exp((double)p.in[I_LDT][g]); const double lr = (double)p.in[I_LRE][i], li = (double)p.in[I_LIM][i];
        const double mag = exp(lr * dt); double ang = li * dt; { const double rv = ang * 0.15915494309189535; ang = (rv - __builtin_rint(rv)) * 6.283185307179586; }
        const double lbr = mag * (double)cosf((float)ang), lbi = mag * (double)sinf((float)ang);
        if (lane == 0) ((f32x2*)(ws + WS_LBAR))[i] = (f32x2){(float)lbr, (float)lbi};
        if (lane == 0) { const double mS = exp(lr * dt * 256.0); double aS = li * dt * 256.0; const double rv = aS * 0.15915494309189535; aS = (rv - __builtin_rint(rv)) * 6.283185307179586;
          ((f32x2*)(ws + WS_LBARS))[i] = (f32x2){(float)(mS * (double)cosf((float)aS)), (float)(mS * (double)sinf((float)aS))}; }
        const double den = lr * lr + li * li, nr = lbr - 1.0;
        const float cr = (float)((nr * lr + lbi * li) / den), ci = (float)((lbi * lr - nr * li) / den);
        bf16* bbm = (bf16*)(ws + WS_BBM); f32x2* bbf = (f32x2*)(ws + WS_BBF); bf16* ccm = (bf16*)(ws + WS_CCM);
        if (lane < 16) { const int h = lane;
            const float br = p.in[I_BRE][i * 16 + h], bi = p.in[I_BIM][i * 16 + h];
            const float xr = cr * br - ci * bi, xi = cr * bi + ci * br;
            bbf[i * 16 + h] = (f32x2){xr, xi};
            bbm[(g * 128 + pp) * 16 + h] = (bf16)f2bf(xr); bbm[(g * 128 + 64 + pp) * 16 + h] = (bf16)f2bf(xi);
            const float c_r = p.in[I_CRE][(g * 16 + h) * 64 + pp], c_i = p.in[I_CIM][(g * 16 + h) * 64 + pp];
            ((unsigned*)ccm)[((g * 16 + h) * 128 + 2 * pp) >> 1] = pk2(c_r, -c_i);
        }
    }
}

struct EpiIn {
    static constexpr bool PERM = true, AFTER_DRAIN = false, HAS_MID = false, KHALVES = false; static constexpr int NF = 1;
    unsigned char* ws; const float* bgate; int cb0;
    __device__ __forceinline__ f32x4 do_rope(f32x4 x, int row, int fq) const {
        const int posidx = (row < MPROMPT) ? (row & 4095) : 4096;
        const f32x2* rp = (const f32x2*)(ws + WS_ROPE) + posidx * 8 + 4 * (fq & 1);
        f32x4 o;
#pragma unroll
        for (int e = 0; e < 4; ++e) { const float pv = __shfl_xor(x[e], 32); const f32x2 cs = rp[e]; o[e] = (fq < 2) ? (x[e] * cs.x - pv * cs.y) : (x[e] * cs.x + pv * cs.y); }
        return o;
    }
    __device__ __forceinline__ void elem(int row, int cb, int cl, f32x4 x, int fq, bool rope_frag) const {
        if (cb < 4) {
            if (rope_frag) x = do_rope(x, row, fq);
            st_bf4((bf16*)(ws + WS_Q) + (size_t)row * 512 + cb * 128 + cl, x * 0.125f);
        } else if (cb < 6) {
            if (cb == 4 && rope_frag) x = do_rope(x, row, fq);
            st_bf4((bf16*)(ws + (cb == 4 ? WS_K : WS_V)) + (size_t)row * 128 + cl, x);
        } else if (cb < 10) {
            st_bf4((bf16*)(ws + WS_U) + (size_t)row * 512 + (cb - 6) * 128 + cl, x);
        } else {
            const int c = (cb - 10) * 128 + cl; const f32x4 b = *(const f32x4*)(bgate + c);
            st_bf4((bf16*)(ws + WS_G) + (size_t)row * 2048 + c, (f32x4){sigm(x[0] + b[0]), sigm(x[1] + b[1]), sigm(x[2] + b[2]), sigm(x[3] + b[3])});
        }
    }
    __device__ __forceinline__ void rope8(f32x4& x0, f32x4& x1, int row, int fq) const {
        const int posidx = (row < MPROMPT) ? (row & 4095) : 4096;
        const f32x4* rp = (const f32x4*)((const f32x2*)(ws + WS_ROPE) + posidx * 8);
        const f32x4 c01 = rp[0], c23 = rp[1], c45 = rp[2], c67 = rp[3];
        const float cs[8] = {c01[0], c23[0], c45[0], c67[0], c01[2], c23[2], c45[2], c67[2]};
        const float sn[8] = {c01[1], c23[1], c45[1], c67[1], c01[3], c23[3], c45[3], c67[3]};
        const float sg = (fq == 0) ? -1.f : 1.f;
#pragma unroll
        for (int e = 0; e < 4; ++e) {
            const float p0 = __shfl_xor(x0[e], 16), p1 = __shfl_xor(x1[e], 16);
            const float r0 = x0[e] * (e == 0 ? c01[0] : e == 1 ? c01[2] : e == 2 ? c23[0] : c23[2]) + sg * p0 * (e == 0 ? c01[1] : e == 1 ? c01[3] : e == 2 ? c23[1] : c23[3]);
            const float r1 = x1[e] * (e == 0 ? c45[0] : e == 1 ? c45[2] : e == 2 ? c67[0] : c67[2]) + sg * p1 * (e == 0 ? c45[1] : e == 1 ? c45[3] : e == 2 ? c67[1] : c67[3]);
            x0[e] = (fq < 2) ? r0 : x0[e]; x1[e] = (fq < 2) ? r1 : x1[e];
        }
        (void)cs; (void)sn;
    }
    __device__ __forceinline__ void operator()(const f32x4 (&acc)[2][2][4][2], const pg8::Unit& un, int wr, int wc, int fr, int fq) const {
#pragma unroll
        for (int bj = 0; bj < 2; ++bj) {
            const int cb = cb0 + 2 * un.pn + bj;
            const int cl = 32 * wc + 8 * fq;
            f32x4 b0 = (f32x4){0.f, 0.f, 0.f, 0.f}, b1 = b0;
            if (cb >= 10) { b0 = *(const f32x4*)(bgate + (cb - 10) * 128 + cl); b1 = *(const f32x4*)(bgate + (cb - 10) * 128 + cl + 4); }
#pragma unroll
            for (int ai = 0; ai < 2; ++ai)
#pragma unroll
                for (int m = 0; m < 4; ++m) {
                    const int row = un.pm * 256 + ai * 128 + wr * 64 + m * 16 + fr;
                    f32x4 x0 = acc[ai][bj][m][0], x1 = acc[ai][bj][m][1];
                    if (cb < 4) {
                        if ((wc & 1) == 0) rope8(x0, x1, row, fq);
                        st_bf8((bf16*)(ws + WS_Q) + (size_t)row * 512 + cb * 128 + cl, x0 * 0.125f, x1 * 0.125f);
                    } else if (cb < 6) {
                        if (cb == 4 && (wc & 1) == 0) rope8(x0, x1, row, fq);
                        st_bf8((bf16*)(ws + (cb == 4 ? WS_K : WS_V)) + (size_t)row * 128 + cl, x0, x1);
                    } else if (cb < 10) {
                        st_bf8((bf16*)(ws + WS_U) + (size_t)row * 512 + (cb - 6) * 128 + cl, x0, x1);
                    } else {
                        const int c = (cb - 10) * 128 + cl;
                        st_bf8((bf16*)(ws + WS_G) + (size_t)row * 2048 + c, (f32x4){sigm(x0[0] + b0[0]), sigm(x0[1] + b0[1]), sigm(x0[2] + b0[2]), sigm(x0[3] + b0[3])},
                               (f32x4){sigm(x1[0] + b1[0]), sigm(x1[1] + b1[1]), sigm(x1[2] + b1[2]), sigm(x1[3] + b1[3])});
                    }
                }
        }
    }
    __device__ __forceinline__ void skinny(const f32x4 (&x)[1], int row, int n0, int fq) const { elem(row, cb0 + (n0 >> 7), (n0 & 127) + 4 * fq, x[0], fq, (n0 & 63) == 0); }
};

struct EpiGlu {
    static constexpr bool PERM = true, AFTER_DRAIN = false, HAS_MID = false, KHALVES = false; static constexpr int NF = 1;
    const bf16* z; bf16* so; const float* b;
    __device__ __forceinline__ void elem(int row, int c, f32x4 x) const {
        const f32x4 bb = *(const f32x4*)(b + c), zz = ld_bf4(z + (size_t)row * 512 + c);
        st_bf4(so + (size_t)row * 1024 + 512 + c, (f32x4){zz[0] * sigm(x[0] + bb[0]), zz[1] * sigm(x[1] + bb[1]), zz[2] * sigm(x[2] + bb[2]), zz[3] * sigm(x[3] + bb[3])});
    }
    __device__ __forceinline__ void operator()(const f32x4 (&acc)[2][2][4][2], const pg8::Unit& un, int wr, int wc, int fr, int fq) const {
#pragma unroll
        for (int ai = 0; ai < 2; ++ai)
#pragma unroll
            for (int m = 0; m < 4; ++m) {
                const int row = un.pm * 256 + ai * 128 + wr * 64 + m * 16 + fr;
#pragma unroll
                for (int bj = 0; bj < 2; ++bj) {
                    const int c = un.pn * 256 + bj * 128 + 32 * wc + 8 * fq;
                    const f32x4 x0 = acc[ai][bj][m][0], x1 = acc[ai][bj][m][1], b0 = *(const f32x4*)(b + c), b1 = *(const f32x4*)(b + c + 4);
                    f32x4 z0, z1; ld_bf8(z + (size_t)row * 512 + c, z0, z1);
                    st_bf8(so + (size_t)row * 1024 + 512 + c, (f32x4){z0[0] * sigm(x0[0] + b0[0]), z0[1] * sigm(x0[1] + b0[1]), z0[2] * sigm(x0[2] + b0[2]), z0[3] * sigm(x0[3] + b0[3])},
                           (f32x4){z1[0] * sigm(x1[0] + b1[0]), z1[1] * sigm(x1[1] + b1[1]), z1[2] * sigm(x1[2] + b1[2]), z1[3] * sigm(x1[3] + b1[3])});
                }
            }
    }
    __device__ __forceinline__ void skinny(const f32x4 (&x)[1], int row, int n0, int fq) const { elem(row, n0 + 4 * fq, x[0]); }
};

struct EpiMerge {
    static constexpr bool PERM = true, AFTER_DRAIN = false, HAS_MID = true, KHALVES = true; static constexpr int NF = 1;
    const bf16* g; bf16* mo;
    __device__ __forceinline__ void mid(f32x4 (&acc)[2][2][4][2], const pg8::Unit& un, int wr, int wc, int fr, int fq) const {
#pragma unroll
        for (int ai = 0; ai < 2; ++ai)
#pragma unroll
            for (int mp = 0; mp < 2; ++mp) {
                asm volatile("" ::: "memory");
                u32x4 w1[2][2], w2[2][2];
#pragma unroll
                for (int mm = 0; mm < 2; ++mm) {
                    const int row = un.pm * 256 + ai * 128 + wr * 64 + (2 * mp + mm) * 16 + fr;
#pragma unroll
                    for (int bj = 0; bj < 2; ++bj) {
                        const int c = un.pn * 256 + bj * 128 + 32 * wc + 8 * fq;
                        w1[mm][bj] = *(const u32x4*)(g + (size_t)row * 2048 + c); w2[mm][bj] = *(const u32x4*)(g + (size_t)row * 2048 + 1024 + c);
                    }
                }
#pragma unroll
                for (int mm = 0; mm < 2; ++mm)
#pragma unroll
                    for (int bj = 0; bj < 2; ++bj) {
                        const u32x4 a = w1[mm][bj], q = w2[mm][bj]; const int m = 2 * mp + mm;
                        const f32x4 p0 = (f32x4){bflo(a.x), bfhi(a.x), bflo(a.y), bfhi(a.y)}, p1 = (f32x4){bflo(a.z), bfhi(a.z), bflo(a.w), bfhi(a.w)};
                        const f32x4 q0 = (f32x4){bflo(q.x), bfhi(q.x), bflo(q.y), bfhi(q.y)}, q1 = (f32x4){bflo(q.z), bfhi(q.z), bflo(q.w), bfhi(q.w)};
                        f32x4 r0, r1;
#pragma unroll
                        for (int e = 0; e < 4; ++e) { r0[e] = p0[e] * __builtin_amdgcn_rcpf(q0[e]); r1[e] = p1[e] * __builtin_amdgcn_rcpf(q1[e]); }
                        acc[ai][bj][m][0] = acc[ai][bj][m][0] * r0; acc[ai][bj][m][1] = acc[ai][bj][m][1] * r1;
                    }
            }
    }
    __device__ __forceinline__ void operator()(const f32x4 (&acc)[2][2][4][2], const pg8::Unit& un, int wr, int wc, int fr, int fq) const {
#pragma unroll
        for (int ai = 0; ai < 2; ++ai)
#pragma unroll
            for (int m = 0; m < 4; ++m) {
                const int row = un.pm * 256 + ai * 128 + wr * 64 + m * 16 + fr;
#pragma unroll
                for (int bj = 0; bj < 2; ++bj) {
                    const int c = un.pn * 256 + bj * 128 + 32 * wc + 8 * fq;
                    f32x4 q0, q1; ld_bf8(g + (size_t)row * 2048 + 1024 + c, q0, q1);
                    st_bf8(mo + (size_t)row * D + c, acc[ai][bj][m][0] * q0, acc[ai][bj][m][1] * q1);
                }
            }
    }
    __device__ __forceinline__ void skinny(const f32x4 (&x)[2], int row, int n0, int fq) const {
        const int c = n0 + 4 * fq;
        st_bf4(mo + (size_t)row * D + c, x[0] * ld_bf4(g + (size_t)row * 2048 + c) + x[1] * ld_bf4(g + (size_t)row * 2048 + 1024 + c));
    }
};

template <int STEP> struct EpiRes {
    static constexpr bool PERM = (STEP == 0), AFTER_DRAIN = false, HAS_MID = false, KHALVES = false; static constexpr int NF = 1;
    const float *xp, *xs; float* out; bf16* xb; float* ss;
    __device__ __forceinline__ float elem(int row, int c, f32x4 x) const {
        if (STEP == 0) {
            const f32x4 r = (row < MPROMPT) ? *(const f32x4*)(xp + (size_t)row * D + c) : *(const f32x4*)(xs + (size_t)(row - MPROMPT) * D + c);
            x = x + r;
            st_bf4(xb + (size_t)row * D + c, x);
        } else {
            x = x + ld_bf4(xb + (size_t)row * D + c); st_bf4(xb + (size_t)row * D + c, x);
        }
        return (x[0] * x[0] + x[1] * x[1]) + (x[2] * x[2] + x[3] * x[3]);
    }
    __device__ __forceinline__ void operator()(const f32x4 (&acc)[2][2][4][2], const pg8::Unit& un, int wr, int wc, int fr, int fq) const {
#pragma unroll
        for (int ai = 0; ai < 2; ++ai)
#pragma unroll
            for (int m = 0; m < 4; ++m) {
                const int row = un.pm * 256 + ai * 128 + wr * 64 + m * 16 + fr;
                float s = 0.f;
                if constexpr (STEP == 0) {
#pragma unroll
                    for (int bj = 0; bj < 2; ++bj) {
                        const int c = un.pn * 256 + bj * 128 + 32 * wc + 8 * fq;
                        const float* xr = (row < MPROMPT) ? xp + (size_t)row * D + c : xs + (size_t)(row - MPROMPT) * D + c;
                        const f32x4 x0 = acc[ai][bj][m][0] + *(const f32x4*)xr, x1 = acc[ai][bj][m][1] + *(const f32x4*)(xr + 4);
                        st_bf8(xb + (size_t)row * D + c, x0, x1);
                        s += ((x0[0] * x0[0] + x0[1] * x0[1]) + (x0[2] * x0[2] + x0[3] * x0[3])) + ((x1[0] * x1[0] + x1[1] * x1[1]) + (x1[2] * x1[2] + x1[3] * x1[3]));
                    }
                } else {
#pragma unroll
                    for (int bj = 0; bj < 2; ++bj)
#pragma unroll
                        for (int n = 0; n < 2; ++n) s += elem(row, un.pn * 256 + bj * 128 + 32 * wc + 16 * n + 4 * fq, acc[ai][bj][m][n]);
                }
                s += __shfl_xor(s, 16); s += __shfl_xor(s, 32);
                if (fq == 0) atomicAdd(ss + row, s);
            }
    }
    __device__ __forceinline__ void skinny(const f32x4 (&x)[1], int row, int n0, int fq) const {
        float s = elem(row, n0 + 4 * fq, x[0]);
        s += __shfl_xor(s, 16); s += __shfl_xor(s, 32);
        if (fq == 0) atomicAdd(ss + row, s);
    }
};

struct EpiFinal {
    static constexpr bool PERM = true, AFTER_DRAIN = true, HAS_MID = false, KHALVES = false; static constexpr int NF = 1;
    const bf16* xb; float* out; float* ss; const float* gf; unsigned* cnt;
    __device__ __forceinline__ void operator()(const f32x4 (&)[2][2][4][2], const pg8::Unit&, int, int, int, int) const {}
    __device__ __forceinline__ void fused(f32x4 (&acc)[2][2][4][2], const pg8::Unit& un, int wr, int wc, int fr, int fq, PG8_LAS unsigned char*, int wid, int lane) const {
#pragma unroll
        for (int ai = 0; ai < 2; ++ai)
#pragma unroll
            for (int m = 0; m < 4; ++m) {
                const int row = un.pm * 256 + ai * 128 + wr * 64 + m * 16 + fr;
                float s = 0.f;
#pragma unroll
                for (int bj = 0; bj < 2; ++bj) {
                    const int c = un.pn * 256 + bj * 128 + 32 * wc + 8 * fq;
                    f32x4 r0, r1; ld_bf8(xb + (size_t)row * D + c, r0, r1);
                    const f32x4 x0 = acc[ai][bj][m][0] + r0, x1 = acc[ai][bj][m][1] + r1;
                    acc[ai][bj][m][0] = x0; acc[ai][bj][m][1] = x1;
                    s += ((x0[0] * x0[0] + x0[1] * x0[1]) + (x0[2] * x0[2] + x0[3] * x0[3])) + ((x1[0] * x1[0] + x1[1] * x1[1]) + (x1[2] * x1[2] + x1[3] * x1[3]));
                }
                s += __shfl_xor(s, 16); s += __shfl_xor(s, 32);
                if (fq == 0) atomicAdd(ss + row, s);
            }
        asm volatile("s_waitcnt vmcnt(0)" ::: "memory"); __syncthreads();
        if (wid == 0 && lane == 0) {
            __builtin_amdgcn_fence(__ATOMIC_RELEASE, "agent"); asm volatile("s_waitcnt vmcnt(0)" ::: "memory");
            __hip_atomic_fetch_add(cnt + 256 + 16 * un.pm, 1u, __ATOMIC_RELAXED, __HIP_MEMORY_SCOPE_AGENT);
            unsigned sp = 0;
            while (__hip_atomic_load(cnt + 256 + 16 * un.pm, __ATOMIC_RELAXED, __HIP_MEMORY_SCOPE_AGENT) < 4u && ++sp < (1u << 22)) __builtin_amdgcn_s_sleep(2);
            __builtin_amdgcn_fence(__ATOMIC_ACQUIRE, "agent"); asm volatile("s_waitcnt vmcnt(0)" ::: "memory");
        }
        __syncthreads();
#pragma unroll
        for (int ai = 0; ai < 2; ++ai)
#pragma unroll
            for (int m = 0; m < 4; ++m) {
                const int row = un.pm * 256 + ai * 128 + wr * 64 + m * 16 + fr;
                const float rstd = 1.f / sqrtf(__hip_atomic_load(ss + row, __ATOMIC_RELAXED, __HIP_MEMORY_SCOPE_AGENT) * (1.f / D) + EPS);
#pragma unroll
                for (int bj = 0; bj < 2; ++bj) {
                    const int c = un.pn * 256 + bj * 128 + 32 * wc + 8 * fq;
                    *(f32x4*)(out + (size_t)row * D + c) = acc[ai][bj][m][0] * rstd * *(const f32x4*)(gf + c);
                    *(f32x4*)(out + (size_t)row * D + c + 4) = acc[ai][bj][m][1] * rstd * *(const f32x4*)(gf + c + 4);
                }
            }
    }
};

struct EpiFfnUp {
    static constexpr bool PERM = true, AFTER_DRAIN = false, HAS_MID = false, KHALVES = false; static constexpr int NF = 2;
    const float* ss; bf16* act;
    __device__ __forceinline__ void elem(int row, int j, f32x4 gt, f32x4 up, float rstd) const {
        gt = gt * rstd; up = up * rstd;
        st_bf4(act + (size_t)row * FF + j, (f32x4){gt[0] * sigm(gt[0]) * up[0], gt[1] * sigm(gt[1]) * up[1], gt[2] * sigm(gt[2]) * up[2], gt[3] * sigm(gt[3]) * up[3]});
    }
    __device__ __forceinline__ void operator()(const f32x4 (&acc)[2][2][4][2], const pg8::Unit& un, int wr, int wc, int fr, int fq) const {
#pragma unroll
        for (int ai = 0; ai < 2; ++ai)
#pragma unroll
            for (int m = 0; m < 4; ++m) {
                const int row = un.pm * 256 + ai * 128 + wr * 64 + m * 16 + fr;
                const float rstd = 1.f / sqrtf(ss[row] * (1.f / D) + EPS);
                const int j = 128 * un.pn + 32 * wc + 8 * fq;
                const f32x4 g0 = acc[ai][0][m][0] * rstd, g1 = acc[ai][0][m][1] * rstd, u0 = acc[ai][1][m][0] * rstd, u1 = acc[ai][1][m][1] * rstd;
                st_bf8(act + (size_t)row * FF + j, (f32x4){g0[0] * sigm(g0[0]) * u0[0], g0[1] * sigm(g0[1]) * u0[1], g0[2] * sigm(g0[2]) * u0[2], g0[3] * sigm(g0[3]) * u0[3]},
                       (f32x4){g1[0] * sigm(g1[0]) * u1[0], g1[1] * sigm(g1[1]) * u1[1], g1[2] * sigm(g1[2]) * u1[2], g1[3] * sigm(g1[3]) * u1[3]});
            }
    }
    __device__ __forceinline__ void skinny(const f32x4 (&x)[2], int row, int j0, int fq) const {
        elem(row, j0 + 4 * fq, x[0], x[1], 1.f / sqrtf(ss[row] * (1.f / D) + EPS));
    }
};

template <class Epi, int K, int MQ> __device__ __forceinline__ void skinny_gemm(unsigned char* lds, const bf16* A, const bf16* Bt, int N, const Epi& E, int bx, int G, int wave, int lane, int lo) {
    constexpr int NF = Epi::NF, MFR = 8 / MQ, KS = K / 8, NSTEP = KS / 32;
    static_assert(KS % 32 == 0, "K slice per wave must be a multiple of 32");
    const int NP = (N / (16 * NF)) * MQ;
    if (bx < lo) return;
    const int fr = lane & 15, fq = lane >> 4;
    f32x4* red = (f32x4*)lds;
    for (int pc = G - 1 - bx; pc < NP; pc += G - lo) {
        const int mq = pc % MQ, pq = pc / MQ, r0 = MPROMPT + mq * 16 * MFR;
        const int n0 = (NF == 2) ? ((pq >> 3) * 256 + (pq & 7) * 16) : pq * 16;
        const int ncol = (NF == 2) ? pq * 16 : n0;
        const bf16* ap = A + (size_t)(r0 + fr) * K + wave * KS + 8 * fq;
        const bf16* bp = Bt + (size_t)(n0 + fr) * K + wave * KS + 8 * fq;
        bf16x8 bfr[NSTEP][NF], afr[NSTEP][MFR];
#pragma unroll
        for (int st = 0; st < NSTEP; ++st) {
#pragma unroll
            for (int nf = 0; nf < NF; ++nf) bfr[st][nf] = *(const bf16x8*)(bp + (size_t)((NF == 2 ? 128 : 16) * nf) * K + 32 * st);
#pragma unroll
            for (int mf = 0; mf < MFR; ++mf) afr[st][mf] = *(const bf16x8*)(ap + (size_t)(16 * mf) * K + 32 * st);
        }
        f32x4 acc[NF][MFR];
#pragma unroll
        for (int nf = 0; nf < NF; ++nf)
#pragma unroll
            for (int mf = 0; mf < MFR; ++mf) acc[nf][mf] = (f32x4){0.f, 0.f, 0.f, 0.f};
#pragma unroll
        for (int st = 0; st < NSTEP; ++st)
#pragma unroll
            for (int nf = 0; nf < NF; ++nf)
#pragma unroll
                for (int mf = 0; mf < MFR; ++mf) acc[nf][mf] = __builtin_amdgcn_mfma_f32_16x16x32_bf16(bfr[st][nf], afr[st][mf], acc[nf][mf], 0, 0, 0);
#pragma unroll
        for (int nf = 0; nf < NF; ++nf)
#pragma unroll
            for (int mf = 0; mf < MFR; ++mf) red[((wave * NF + nf) * MFR + mf) * 64 + lane] = acc[nf][mf];
        __syncthreads();
        if (wave < MFR) {
            if constexpr (Epi::KHALVES) {
                f32x4 x[2];
#pragma unroll
                for (int hf = 0; hf < 2; ++hf) {
                    f32x4 t = red[((4 * hf) * MFR + wave) * 64 + lane];
#pragma unroll
                    for (int w = 1; w < 4; ++w) t = t + red[((4 * hf + w) * MFR + wave) * 64 + lane];
                    x[hf] = t;
                }
                E.skinny(x, r0 + 16 * wave + fr, ncol, fq);
            } else {
                f32x4 x[NF];
#pragma unroll
                for (int nf = 0; nf < NF; ++nf) {
                    f32x4 t = red[((0 * NF + nf) * MFR + wave) * 64 + lane];
#pragma unroll
                    for (int w = 1; w < 8; ++w) t = t + red[((w * NF + nf) * MFR + wave) * 64 + lane];
                    x[nf] = t;
                }
                E.skinny(x, r0 + 16 * wave + fr, ncol, fq);
            }
        }
        __syncthreads();
    }
}

__device__ __forceinline__ void attn_prompt_item(const Params& p, unsigned char* lds, int item, int tid, bf16* obuf) {
    unsigned char* ws = p.ws;
    const int kvh = item & 1, n = (item >> 1) & 31, b = item >> 6;
    bf16* Ks = (bf16*)lds;
    bf16* VT = (bf16*)(lds + 36864);
    const bf16* kbuf = (const bf16*)(ws + WS_K); const bf16* vbuf = (const bf16*)(ws + WS_V); bf16* qbuf = (bf16*)(ws + WS_Q);
#pragma unroll
    for (int i = 0; i < 4; ++i) {
        const int c = tid + NTHREADS * i, r = c >> 3, ch = c & 7; const int trow = (n - 1) * 128 + r;
        u32x4 kk = (u32x4){0u, 0u, 0u, 0u}, vv = kk;
        if (trow >= 0) { const size_t go = (size_t)(b * TPR + trow) * 128 + kvh * 64 + ch * 8; kk = *(const u32x4*)(kbuf + go); vv = *(const u32x4*)(vbuf + go); }
        *(u32x4*)(Ks + r * 72 + ch * 8) = kk;
        if (n == 31 && r >= 128) {
            float* ko = p.out + O_KWP + ((size_t)(b * 128 + (r - 128)) * 2 + kvh) * 64 + ch * 8; float* vo = p.out + O_VWP + ((size_t)(b * 128 + (r - 128)) * 2 + kvh) * 64 + ch * 8;
            *(f32x4*)ko = (f32x4){bflo(kk.x), bfhi(kk.x), bflo(kk.y), bfhi(kk.y)}; *(f32x4*)(ko + 4) = (f32x4){bflo(kk.z), bfhi(kk.z), bflo(kk.w), bfhi(kk.w)};
            *(f32x4*)vo = (f32x4){bflo(vv.x), bfhi(vv.x), bflo(vv.y), bfhi(vv.y)}; *(f32x4*)(vo + 4) = (f32x4){bflo(vv.z), bfhi(vv.z), bflo(vv.w), bfhi(vv.w)};
        }
        bf16* vd = VT + (ch * 8) * 264 + r;
        vd[0 * 264] = (bf16)(vv.x & 0xffffu); vd[1 * 264] = (bf16)(vv.x >> 16); vd[2 * 264] = (bf16)(vv.y & 0xffffu); vd[3 * 264] = (bf16)(vv.y >> 16);
        vd[4 * 264] = (bf16)(vv.z & 0xffffu); vd[5 * 264] = (bf16)(vv.z >> 16); vd[6 * 264] = (bf16)(vv.w & 0xffffu); vd[7 * 264] = (bf16)(vv.w >> 16);
    }
    __syncthreads();
    const int wave = tid >> 6, lane = tid & 63, fr = lane & 15, fq = lane >> 4;
    const int i0 = 16 * wave, kb = i0 < 96 ? i0 : 96;
    const int qi = i0 + fr;
    const size_t qrow = (size_t)(b * TPR + n * 128 + qi);
    const int jlo = (n == 0) ? (qi + 1 > 128 ? qi + 1 : 128) : qi + 1; const int jbase = kb + 4 * fq - jlo; const unsigned jlim = (unsigned)(qi + 128 - jlo);
    bf16x8 qn0 = *(const bf16x8*)(qbuf + qrow * 512 + kvh * 256 + 8 * fq), qn1 = *(const bf16x8*)(qbuf + qrow * 512 + kvh * 256 + 8 * fq + 32);
#pragma unroll 1
    for (int hh = 0; hh < 4; ++hh) {
        const int h = kvh * 4 + hh;
        const float sink = p.in[I_SINK][h];
        bf16* qp = qbuf + qrow * 512 + h * 64;
        const bf16x8 q0 = qn0, q1 = qn1;
        asm volatile("" ::: "memory");
        { const bf16* qnx = qbuf + qrow * 512 + (kvh * 4 + (hh < 3 ? hh + 1 : 3)) * 64; qn0 = *(const bf16x8*)(qnx + 8 * fq); qn1 = *(const bf16x8*)(qnx + 8 * fq + 32); }
        f32x4 s[10];
#pragma unroll
        for (int f = 0; f < 10; ++f) {
            const bf16* kp = Ks + (kb + 16 * f + fr) * 72 + 8 * fq;
            f32x4 a = (f32x4){0.f, 0.f, 0.f, 0.f};
            a = __builtin_amdgcn_mfma_f32_16x16x32_bf16(*(const bf16x8*)kp, q0, a, 0, 0, 0);
            a = __builtin_amdgcn_mfma_f32_16x16x32_bf16(*(const bf16x8*)(kp + 32), q1, a, 0, 0, 0);
            s[f] = a;
        }
        float mx = sink;
#pragma unroll
        for (int f = 0; f < 10; ++f)
#pragma unroll
            for (int r = 0; r < 4; ++r) { const bool ok = (unsigned)(jbase + 16 * f + r) <= jlim;
                s[f][r] = ok ? s[f][r] : -__builtin_inff(); mx = fmaxf(mx, s[f][r]); }
        mx = fmaxf(mx, __shfl_xor(mx, 16)); mx = fmaxf(mx, __shfl_xor(mx, 32));
        float sum = 0.f;
#pragma unroll
        for (int f = 0; f < 10; ++f)
#pragma unroll
            for (int r = 0; r < 4; ++r) { const float e = __expf(s[f][r] - mx); s[f][r] = e; sum += e; }
        sum += __shfl_xor(sum, 16); sum += __shfl_xor(sum, 32);
        sum += __expf(sink - mx);
        const float inv = 1.f / sum;
        bf16x8 pb[5];
#pragma unroll
        for (int m = 0; m < 5; ++m) { u32x4 w; w.x = pk2(s[2 * m][0], s[2 * m][1]); w.y = pk2(s[2 * m][2], s[2 * m][3]); w.z = pk2(s[2 * m + 1][0], s[2 * m + 1][1]); w.w = pk2(s[2 * m + 1][2], s[2 * m + 1][3]);
            pb[m] = __builtin_bit_cast(bf16x8, w); }
#pragma unroll
        for (int df = 0; df < 4; ++df) {
            f32x4 o = (f32x4){0.f, 0.f, 0.f, 0.f};
            const bf16* vp = VT + (16 * df + fr) * 264 + kb + 4 * fq;
#pragma unroll
            for (int m = 0; m < 5; ++m) {
                const u32x2 lo = *(const u32x2*)(vp + 32 * m), hi = *(const u32x2*)(vp + 32 * m + 16);
                const u32x4 w = (u32x4){lo.x, lo.y, hi.x, hi.y};
                o = __builtin_amdgcn_mfma_f32_16x16x32_bf16(__builtin_bit_cast(bf16x8, w), pb[m], o, 0, 0, 0);
            }
            st_bf4(obuf + qrow * 1024 + h * 64 + 16 * df + 4 * fq, o * inv);
        }
    }
    __syncthreads();
}

__device__ __forceinline__ void attn_sample_block(const Params& p, unsigned char* lds, int item, int tid) {
    unsigned char* ws = p.ws;
    const int kvh = item & 1, db = item >> 1, lane = tid & 63, wave = tid >> 6;
    float* qs = (float*)lds;
    float* sc = (float*)(lds + 1024);
    float* red = (float*)(lds + 3072);
    bf16* qbuf = (bf16*)(ws + WS_Q);
    const size_t row = (size_t)(MPROMPT + db);
    if (tid < 256) qs[tid] = bf2f(qbuf[row * 512 + kvh * 256 + tid]);
    const int key = tid >> 2, part = tid & 3;
    f32x4 kv[4];
    {
        float* dst = p.out + O_KWS + ((size_t)(db * 128 + key) * 2 + kvh) * 64 + part * 16;
        if (key < 127) {
            const float* src = p.in[I_SK] + ((size_t)(db * 128 + key + 1) * 2 + kvh) * 64 + part * 16;
#pragma unroll
            for (int c = 0; c < 4; ++c) kv[c] = *(const f32x4*)(src + 4 * c);
        } else {
            const bf16* src = (const bf16*)(ws + WS_K) + row * 128 + kvh * 64 + part * 16;
#pragma unroll
            for (int c = 0; c < 4; ++c) kv[c] = ld_bf4(src + 4 * c);
        }
#pragma unroll
        for (int c = 0; c < 4; ++c) *(f32x4*)(dst + 4 * c) = kv[c];
    }
    __syncthreads();
    {
        float a[4];
#pragma unroll
        for (int hh = 0; hh < 4; ++hh) {
            float t = 0.f;
#pragma unroll
            for (int c = 0; c < 4; ++c) { const f32x4 w = *(const f32x4*)(qs + hh * 64 + part * 16 + 4 * c); t += kv[c][0] * w[0] + kv[c][1] * w[1] + kv[c][2] * w[2] + kv[c][3] * w[3]; }
            t += __shfl_xor(t, 1); t += __shfl_xor(t, 2); a[hh] = t;
        }
        if (part == 0) { sc[key] = a[0]; sc[128 + key] = a[1]; sc[256 + key] = a[2]; sc[384 + key] = a[3]; }
    }
    __syncthreads();
    if (wave < 4) {
        const float sink = p.in[I_SINK][kvh * 4 + wave];
        const float s0 = sc[wave * 128 + lane], s1 = sc[wave * 128 + 64 + lane];
        const float mx = fmaxf(wave_max(fmaxf(s0, s1)), sink);
        const float e0 = __expf(s0 - mx), e1 = __expf(s1 - mx);
        const float inv = 1.f / (wave_sum(e0 + e1) + __expf(sink - mx));
        sc[wave * 128 + lane] = e0 * inv; sc[wave * 128 + 64 + lane] = e1 * inv;
    }
    __syncthreads();
    {
        const int chunk = tid & 15, kg = tid >> 4;
        f32x4 vv[4];
#pragma unroll
        for (int i = 0; i < 4; ++i) {
            const int k2 = kg * 4 + i;
            if (k2 < 127) vv[i] = *(const f32x4*)(p.in[I_SV] + ((size_t)(db * 128 + k2 + 1) * 2 + kvh) * 64 + chunk * 4);
            else vv[i] = ld_bf4((const bf16*)(ws + WS_V) + row * 128 + kvh * 64 + chunk * 4);
            *(f32x4*)(p.out + O_VWS + ((size_t)(db * 128 + k2) * 2 + kvh) * 64 + chunk * 4) = vv[i];
        }
        f32x4 o[4];
#pragma unroll
        for (int hh = 0; hh < 4; ++hh) {
            f32x4 t = (f32x4){0.f, 0.f, 0.f, 0.f};
#pragma unroll
            for (int i = 0; i < 4; ++i) t = t + vv[i] * sc[hh * 128 + kg * 4 + i];
#pragma unroll
            for (int e = 0; e < 4; ++e) { t[e] += __shfl_xor(t[e], 16); t[e] += __shfl_xor(t[e], 32); }
            o[hh] = t;
        }
        if (lane < 16) {
#pragma unroll
            for (int hh = 0; hh < 4; ++hh) *(f32x4*)(red + (wave * 4 + hh) * 64 + chunk * 4) = o[hh];
        }
    }
    __syncthreads();
    if (tid < 256) {
        float t = 0.f;
#pragma unroll
        for (int w = 0; w < 8; ++w) t += red[w * 256 + tid];
        ((bf16*)(ws + WS_AS))[row * 1024 + kvh * 256 + tid] = (bf16)f2bf(t);
    }
    __syncthreads();
}

template <bool PB> __device__ __forceinline__ void ssm_item(const Params& p, unsigned char* ldsw, int item, int lane) {
    unsigned char* ws = p.ws;
    const int seg = item & 15, g = (item >> 4) & 31, b = item >> 9;
    const int fr = lane & 15, fq = lane >> 4;
    float* BuT = (float*)ldsw;
    bf16* hc = (bf16*)(ldsw + 10240);
    const f32x2 lb = ((const f32x2*)(ws + WS_LBAR))[g * 64 + lane];
    const bf16* bbm = (const bf16*)(ws + WS_BBM); const bf16* ccm = (const bf16*)(ws + WS_CCM);
    bf16x4 bb[8];
#pragma unroll
    for (int f = 0; f < 8; ++f) bb[f] = *(const bf16x4*)(bbm + ((size_t)(g * 128 + 16 * f + fr) * 16 + 4 * fq));
    bf16x8 cc[4]; f32x4 dv = (f32x4){0.f, 0.f, 0.f, 0.f};
    if (PB) {
#pragma unroll
        for (int s = 0; s < 4; ++s) cc[s] = *(const bf16x8*)(ccm + ((size_t)(g * 16 + fr) * 128 + 8 * fq + 32 * s));
        dv = *(const f32x4*)(p.in[I_SD] + g * 16 + 4 * fq);
    }
    float hr = 0.f, hi = 0.f;
    f32x2* E = (f32x2*)(ws + WS_E);
    if (PB) {
        const f32x2 ls = ((const f32x2*)(ws + WS_LBARS))[g * 64 + lane];
        f32x2 ev[15];
#pragma unroll
        for (int j = 0; j < 15; ++j) ev[j] = E[((size_t)((b * 32 + g) * 16 + (j < seg ? j : 0))) * 64 + lane];
#pragma unroll
        for (int j = 0; j < 15; ++j) { const float nr = ls.x * hr - ls.y * hi + ev[j].x, ni = ls.x * hi + ls.y * hr + ev[j].y; hr = (j < seg) ? nr : hr; hi = (j < seg) ? ni : hi; }
    }
    const size_t row0 = (size_t)b * TPR + seg * 256;
    const bf16* up = (const bf16*)(ws + WS_U) + (row0 + fr) * 512 + g * 16 + 4 * fq;
    bf16* zb = (bf16*)(ws + WS_Z);
    u32x2 uw_n = *(const u32x2*)up;
    for (int ch = 0; ch < 16; ++ch) {
        const u32x2 uw = uw_n;
        uw_n = *(const u32x2*)(up + (size_t)(ch < 15 ? ch + 1 : 15) * 16 * 512);
        const bf16x4 ua = __builtin_bit_cast(bf16x4, uw);
#pragma unroll
        for (int f = 0; f < 8; ++f) {
            f32x4 a = (f32x4){0.f, 0.f, 0.f, 0.f};
            a = __builtin_amdgcn_mfma_f32_16x16x16bf16_1k(ua, bb[f], a, 0, 0, 0);
            *(f32x4*)(BuT + (16 * f + fr) * 20 + 4 * fq) = a;
        }
        LDS_WAIT();
#pragma unroll
        for (int j = 0; j < 4; ++j) {
            const f32x4 r4 = *(const f32x4*)(BuT + lane * 20 + 4 * j), i4 = *(const f32x4*)(BuT + (64 + lane) * 20 + 4 * j);
#pragma unroll
            for (int e = 0; e < 4; ++e) {
                const float nr = lb.x * hr - lb.y * hi + r4[e], ni = lb.x * hi + lb.y * hr + i4[e]; hr = nr; hi = ni;
                if (PB) *(unsigned*)(hc + (4 * j + e) * 136 + 2 * lane) = pk2(hr, hi);
            }
        }
        if (PB) {
            LDS_WAIT();
            f32x4 y = (f32x4){0.f, 0.f, 0.f, 0.f};
#pragma unroll
            for (int s = 0; s < 4; ++s) y = __builtin_amdgcn_mfma_f32_16x16x32_bf16(cc[s], *(const bf16x8*)(hc + fr * 136 + 8 * fq + 32 * s), y, 0, 0, 0);
            const f32x4 uf = (f32x4){bflo(uw.x), bfhi(uw.x), bflo(uw.y), bfhi(uw.y)};
            y = y + dv * uf;
            st_bf4(zb + (row0 + ch * 16 + fr) * 512 + g * 16 + 4 * fq, (f32x4){gelu_tanh(y[0]), gelu_tanh(y[1]), gelu_tanh(y[2]), gelu_tanh(y[3])});
        }
        LDS_WAIT();
    }
    if (!PB) E[((size_t)((b * 32 + g) * 16 + seg)) * 64 + lane] = (f32x2){hr, hi};
    else if (seg == NSEG - 1) { p.out[O_SRP + (size_t)(b * 32 + g) * 64 + lane] = hr; p.out[O_SIP + (size_t)(b * 32 + g) * 64 + lane] = hi; }
}

template <int NI> __device__ __forceinline__ void ssm_sample_items(const Params& p, unsigned char* ldsw, int item0, int istep, int lane) {
    unsigned char* ws = p.ws;
    float* hs = (float*)ldsw;
    const int ho = lane & 15, part = lane >> 4;
    u32x4 u0[NI], u1[NI]; f32x4 bw[NI][8]; f32x2 lb[NI]; float h0r[NI], h0i[NI], dsk[NI]; f32x4 crr[NI][4], cii[NI][4];
#pragma unroll
    for (int k = 0; k < NI; ++k) {
        const int item = item0 + k * istep, g = item & 31, db = item >> 5;
        const bf16* up = (const bf16*)(ws + WS_U) + (size_t)(MPROMPT + db) * 512 + g * 16;
        u0[k] = *(const u32x4*)up; u1[k] = *(const u32x4*)(up + 8);
        const f32x4* bbf = (const f32x4*)((const f32x2*)(ws + WS_BBF) + (size_t)(g * 64 + lane) * 16);
#pragma unroll
        for (int h = 0; h < 8; ++h) bw[k][h] = bbf[h];
        lb[k] = ((const f32x2*)(ws + WS_LBAR))[g * 64 + lane];
        h0r[k] = p.in[I_SRE][(size_t)(db * 32 + g) * 64 + lane]; h0i[k] = p.in[I_SIM][(size_t)(db * 32 + g) * 64 + lane];
        const f32x4* cr = (const f32x4*)(p.in[I_CRE] + (size_t)(g * 16 + ho) * 64 + part * 16); const f32x4* ci = (const f32x4*)(p.in[I_CIM] + (size_t)(g * 16 + ho) * 64 + part * 16);
#pragma unroll
        for (int q = 0; q < 4; ++q) { crr[k][q] = cr[q]; cii[k][q] = ci[q]; }
        dsk[k] = p.in[I_SD][g * 16 + ho];
    }
    float uo[NI];
#pragma unroll
    for (int k = 0; k < NI; ++k) {
        const int item = item0 + k * istep, g = item & 31, db = item >> 5;
        const float uf[16] = {bflo(u0[k].x), bfhi(u0[k].x), bflo(u0[k].y), bfhi(u0[k].y), bflo(u0[k].z), bfhi(u0[k].z), bflo(u0[k].w), bfhi(u0[k].w),
                              bflo(u1[k].x), bfhi(u1[k].x), bflo(u1[k].y), bfhi(u1[k].y), bflo(u1[k].z), bfhi(u1[k].z), bflo(u1[k].w), bfhi(u1[k].w)};
        float br = 0.f, bi = 0.f;
#pragma unroll
        for (int h = 0; h < 8; ++h) { const f32x4 w = bw[k][h]; br += w[0] * uf[2 * h] + w[2] * uf[2 * h + 1]; bi += w[1] * uf[2 * h] + w[3] * uf[2 * h + 1]; }
        const float hr = lb[k].x * h0r[k] - lb[k].y * h0i[k] + br, hi = lb[k].x * h0i[k] + lb[k].y * h0r[k] + bi;
        p.out[O_SRS + (size_t)(db * 32 + g) * 64 + lane] = hr; p.out[O_SIS + (size_t)(db * 32 + g) * 64 + lane] = hi;
        hs[k * 128 + lane] = hr; hs[k * 128 + 64 + lane] = hi;
        float t = uf[0];
#pragma unroll
        for (int q = 1; q < 16; ++q) t = (ho == q) ? uf[q] : t;
        uo[k] = t;
    }
    LDS_WAIT();
#pragma unroll
    for (int k = 0; k < NI; ++k) {
        const int item = item0 + k * istep, g = item & 31, db = item >> 5;
        const f32x4* hr4 = (const f32x4*)(hs + k * 128 + part * 16); const f32x4* hi4 = (const f32x4*)(hs + k * 128 + 64 + part * 16);
        const f32x4 t = crr[k][0] * hr4[0] + crr[k][1] * hr4[1] + crr[k][2] * hr4[2] + crr[k][3] * hr4[3] - cii[k][0] * hi4[0] - cii[k][1] * hi4[1] - cii[k][2] * hi4[2] - cii[k][3] * hi4[3];
        float y = (t[0] + t[1]) + (t[2] + t[3]);
        y += __shfl_xor(y, 16); y += __shfl_xor(y, 32);
        y += dsk[k] * uo[k];
        if (part == 0) ((bf16*)(ws + WS_Z))[(size_t)(MPROMPT + db) * 512 + g * 16 + ho] = (bf16)f2bf(gelu_tanh(y));
    }
    LDS_WAIT();
}

#define XB_TMO      128
#define XB_XCNT(j)  (256  + 64 * (j))
#define XB_XSUB(j)  (1280 + 64 * (j))
#define XB_XGEN(j)  (2304 + 64 * (j))
#define XB_TOP      3328
#define XB_TOPGEN   3392
#define XCD_BAR_WORDS 3456
#define XB_SPIN_CAP (1u << 18)

__device__ __forceinline__ unsigned xb_ld(unsigned* p)              { return __hip_atomic_load(p, __ATOMIC_RELAXED, __HIP_MEMORY_SCOPE_AGENT); }
__device__ __forceinline__ unsigned xb_add(unsigned* p, unsigned v) { return __hip_atomic_fetch_add(p, v, __ATOMIC_RELAXED, __HIP_MEMORY_SCOPE_AGENT); }
__device__ __forceinline__ unsigned xb_xcc_id() { return (unsigned)__builtin_amdgcn_s_getreg((3 << 11) | 20) & 0xFu; }
#define XB_SPIN(cond, bar) do { unsigned _sp = 0; while (cond) { __builtin_amdgcn_s_sleep(1); \
    if ((++_sp & 255u) == 0u) { if (xb_ld(&(bar)[XB_TMO])) break; if (_sp > XB_SPIN_CAP) { atomicAdd(&(bar)[XB_TMO], 1u); break; } } } } while (0)

struct XcdBarrier {
    unsigned* bar; unsigned x;
    volatile LAS unsigned* st;
};

__device__ __forceinline__ XcdBarrier xcd_barrier_post(unsigned* bar, volatile LAS unsigned* st) {
    XcdBarrier b; b.bar = bar; b.x = xb_xcc_id(); b.st = st;
    if (threadIdx.x == 0) (void)xb_add(&bar[XB_XCNT(b.x)], 1u);
    return b;
}
__device__ __forceinline__ void xcd_barrier_complete(unsigned* bar, unsigned x, unsigned& nloc, unsigned& nx) {
    const unsigned G = gridDim.x * gridDim.y * gridDim.z;
    unsigned sum, cnt, mine, sp = 0u;
    for (;;) {
        sum = 0u; cnt = 0u; mine = 0u;
#pragma unroll
        for (unsigned j = 0; j < 16; ++j) { const unsigned c = xb_ld(&bar[XB_XCNT(j)]); sum += c; cnt += (c > 0u) ? 1u : 0u; mine = (j == x) ? c : mine; }
        if (sum == G) break;
        __builtin_amdgcn_s_sleep(1);
        if ((++sp & 255u) == 0u) { if (xb_ld(&bar[XB_TMO])) break; if (sp > XB_SPIN_CAP) { atomicAdd(&bar[XB_TMO], 1u); break; } }
    }
    nloc = mine > 0u ? mine : 1u; nx = cnt > 0u ? cnt : 1u;
}

__device__ __forceinline__ void xcd_barrier(const XcdBarrier& b, const bool is_t0) {
    asm volatile("s_waitcnt vmcnt(0)" ::: "memory");
    __syncthreads();
    if (is_t0) {
        unsigned* bar = b.bar;
        __builtin_amdgcn_s_waitcnt(0);
        unsigned nloc = b.st[0], nx = b.st[1];
        if (nloc == 0u) { xcd_barrier_complete(bar, b.x, nloc, nx); b.st[0] = nloc; b.st[1] = nx; }
        const unsigned old = xb_add(&bar[XB_XSUB(b.x)], 1u);
        const unsigned gen = old / nloc;
        if (old + 1u == (gen + 1u) * nloc) {
            __builtin_amdgcn_fence(__ATOMIC_RELEASE, "agent");
            asm volatile("s_waitcnt vmcnt(0)" ::: "memory");
            const unsigned og = xb_add(&bar[XB_TOP], 1u);
            const unsigned tg = og / nx;
            if (og + 1u == (tg + 1u) * nx) xb_add(&bar[XB_TOPGEN], 1u);
            else XB_SPIN(xb_ld(&bar[XB_TOPGEN]) == tg, bar);
            __builtin_amdgcn_fence(__ATOMIC_ACQUIRE, "agent");
            xb_add(&bar[XB_XGEN(b.x)], 1u);
            asm volatile("s_waitcnt vmcnt(0)" ::: "memory");
        } else {
            XB_SPIN(xb_ld(&bar[XB_XGEN(b.x)]) == gen, bar);
            __builtin_amdgcn_fence(__ATOMIC_ACQUIRE, "agent");
            asm volatile("s_waitcnt vmcnt(0)" ::: "memory");
        }
    }
    __syncthreads();
}

#ifndef XPROBE
#define XPROBE 0
#endif
#ifndef DUP
#define DUP 0
#endif
#ifndef P2S
#define P2S 15
#endif
#ifndef PH
#define PH 0x3ff
#endif
__global__ void __launch_bounds__(NTHREADS, 2) mk_fwd(Params p) {
    extern __shared__ __attribute__((aligned(16))) unsigned char lds[];
    cg::grid_group grid = cg::this_grid();
    const int wave = __builtin_amdgcn_readfirstlane(threadIdx.x >> 6);
    const int G = gridDim.x, bx = blockIdx.x;
    const int gw = bx * NWAVES + wave, NGW = G * NWAVES;
    unsigned char* ws = p.ws;
    PG8_LAS unsigned char* ldsg = (PG8_LAS unsigned char*)lds;
    if (gridDim.x == 0x7fffffffu) grid.sync();
    if (threadIdx.x < 4) ((volatile LAS unsigned*)(ldsg + 131072 + 64))[threadIdx.x] = 0u;
    __syncthreads();
    (void)xcd_barrier_post((unsigned*)(ws + WS_BAR), (volatile LAS unsigned*)(ldsg + 131072 + 64));
#define GRID_BAR() do { XcdBarrier b_; b_.bar = (unsigned*)(p.ws + WS_BAR); b_.x = xb_xcc_id(); b_.st = (volatile LAS unsigned*)(ldsg + 131072 + 64); xcd_barrier(b_, wave == 0 && fresh_lane() == 0); } while (0)

#if PH & (1<<0)
    for (int rep_ = 0; rep_ < 1 + ((DUP >> 0) & 1); ++rep_) {
    { int lane_ = fresh_lane();
    p0_weights(p, lds, 0, P0_I0 + 8 * 16, gw, NGW, wave, lane_);
    p0_prologue(p, lds, gw, NGW, wave, lane_); }
    GRID_BAR();

    }
#endif
#if PH & (1<<1)
    for (int rep_ = 0; rep_ < 1 + ((DUP >> 1) & 1); ++rep_) {
    {
        pg8::Gemm g{(const bf16*)(ws + WS_XB), (const bf16*)(ws + WS_WIN), MPROMPT, 3072, D}; pg8::StaticOrder S; S.init(MPROMPT, 3072, G, bx);
        EpiIn E{ws, p.in[I_BG], 0};
        { int lane_ = fresh_lane(); skinny_gemm<EpiIn, 1024, 1>(lds, g.A, g.Bt, 3072, E, bx, G, wave, lane_, 0); }
        pg8::gemm_phase<EpiIn, pg8::StaticOrder, true, true>(ldsg, g, S, E, wave, wave * 64 + fresh_lane());
    }
    GRID_BAR();

    }
#endif
#if PH & (1<<2)
    for (int rep_ = 0; rep_ < 1 + ((DUP >> 2) & 1); ++rep_) {
#if P2S & 1
#if XPROBE & 1
    for (int it = bx; it < 256; it += G) { int tid_ = wave * 64 + fresh_lane(); attn_prompt_item(p, lds, it, tid_, (bf16*)(ws + WS_M)); }
#endif
    for (int it = bx; it < 256; it += G) { int tid_ = wave * 64 + fresh_lane(); attn_prompt_item(p, lds, it, tid_, (bf16*)(ws + WS_AS)); }
    }
#endif
#if P2S & 2
    for (int it = bx; it < 256; it += G) { int tid_ = wave * 64 + fresh_lane(); attn_sample_block(p, lds, it, tid_); }
#endif
#if XPROBE & 2
    for (int it = gw; it < 2048; it += NGW) { int lane_ = fresh_lane(); ssm_item<false>(p, lds + wave * 16384, it, lane_); }
    { int it = gw; for (; it + NGW < 4096; it += 2 * NGW) { int lane_ = fresh_lane(); ssm_sample_items<2>(p, lds + wave * 16384, it, NGW, lane_); }
      if (it < 4096) { int lane_ = fresh_lane(); ssm_sample_items<1>(p, lds + wave * 16384, it, NGW, lane_); } }
#endif
#if P2S & 4
    for (int it = gw; it < 2048; it += NGW) { int lane_ = fresh_lane(); ssm_item<false>(p, lds + wave * 16384, it, lane_); }
#endif
#if P2S & 8
    { int it = gw; for (; it + NGW < 4096; it += 2 * NGW) { int lane_ = fresh_lane(); ssm_sample_items<2>(p, lds + wave * 16384, it, NGW, lane_); }
      if (it < 4096) { int lane_ = fresh_lane(); ssm_sample_items<1>(p, lds + wave * 16384, it, NGW, lane_); } }
#endif
    GRID_BAR();

#endif
#if PH & (1<<3)
    for (int rep_ = 0; rep_ < 1 + ((DUP >> 3) & 1); ++rep_) {
    for (int it = gw; it < 2048; it += NGW) { int lane_ = fresh_lane(); ssm_item<true>(p, lds + wave * 16384, it, lane_); }
    GRID_BAR();

    }
#endif
#if PH & (1<<4)
    for (int rep_ = 0; rep_ < 1 + ((DUP >> 4) & 1); ++rep_) {
    {
        const bool g256 = (G == 256);
        pg8::Gemm g{(const bf16*)(ws + WS_Z), (const bf16*)(ws + WS_WGLU), MPROMPT, 512, 512}; pg8::StaticOrder S; S.init(MPROMPT, 512, G, bx);
        EpiGlu E{(const bf16*)(ws + WS_Z), (bf16*)(ws + WS_AS), p.in[I_BGLU]};
        pg8::Gemm g2{(const bf16*)(ws + WS_XB), (const bf16*)(ws + WS_WIN) + (size_t)3072 * D, MPROMPT, 256, D}; pg8::StaticOrder S2;
        if (g256) S2.init(MPROMPT, 256, 64, (bx >= 128 && bx < 192) ? bx - 128 : (1 << 20)); else S2.init(MPROMPT, 256, G, bx);
        EpiIn E2{ws, p.in[I_BG], 24};
        const int lo4 = g256 ? 192 : 0;
        { int lane_ = fresh_lane(); skinny_gemm<EpiGlu, 512, 1>(lds, g.A, g.Bt, 512, E, bx, G, wave, lane_, lo4); }
        { int lane_ = fresh_lane(); skinny_gemm<EpiIn, 1024, 1>(lds, g2.A, g2.Bt, 256, E2, bx, G, wave, lane_, lo4); }
        pg8::gemm_phase<EpiGlu, pg8::StaticOrder, true, true>(ldsg, g, S, E, wave, wave * 64 + fresh_lane());
        pg8::gemm_phase<EpiIn, pg8::StaticOrder, true, true>(ldsg, g2, S2, E2, wave, wave * 64 + fresh_lane());
        {
            constexpr int W0 = P0_I0 + 8 * 16, WSPLIT = W0 + 1792, WDOWN = P0_NITEMS - 44 * 32;
            const int lane_ = fresh_lane();
            if (!g256) p0_weights(p, lds, W0, P0_NITEMS, gw, NGW, wave, lane_);
            else if (bx < 128) p0_weights(p, lds, W0, WSPLIT, bx * NWAVES + wave, 128 * NWAVES, wave, lane_);
            else if (bx >= 192) p0_weights(p, lds, WSPLIT, WDOWN, (bx - 192) * NWAVES + wave, 64 * NWAVES, wave, lane_);
        }
    }
    GRID_BAR();

    }
#endif
#if PH & (1<<5)
    for (int rep_ = 0; rep_ < 1 + ((DUP >> 5) & 1); ++rep_) {
    {
        pg8::Gemm g{(const bf16*)(ws + WS_AS), (const bf16*)(ws + WS_WBA), MPROMPT, D, D}; pg8::StaticOrder S; S.init(MPROMPT, D, G, bx);
        EpiMerge E{(const bf16*)(ws + WS_G), (bf16*)(ws + WS_M)};
        { int lane_ = fresh_lane(); skinny_gemm<EpiMerge, 1024, 4>(lds, g.A, g.Bt, D, E, bx, G, wave, lane_, 0); }
        pg8::gemm_phase<EpiMerge, pg8::StaticOrder, true, true>(ldsg, g, S, E, wave, wave * 64 + fresh_lane());
    }
    GRID_BAR();

    }
#endif
#if PH & (1<<6)
    for (int rep_ = 0; rep_ < 1 + ((DUP >> 6) & 1); ++rep_) {
    {
        pg8::Gemm g{(const bf16*)(ws + WS_M), (const bf16*)(ws + WS_WOUT), MPROMPT, D, D}; pg8::StaticOrder S; S.init(MPROMPT, D, G, bx);
        EpiRes<0> E{p.in[I_XP], p.in[I_XS], p.out, (bf16*)(ws + WS_XB), (float*)(ws + WS_SS1)};
#if XPROBE & 8
        { EpiRes<0> E2{p.in[I_XP], p.in[I_XS], (float*)(ws + WS_ACT), (bf16*)(ws + WS_XB), (float*)(ws + WS_E)};
          pg8::gemm_phase<EpiRes<0>, pg8::StaticOrder, true, true>(ldsg, g, S, E2, wave, wave * 64 + fresh_lane()); }
#endif
        { int lane_ = fresh_lane(); skinny_gemm<EpiRes<0>, 1024, 4>(lds, g.A, g.Bt, D, E, bx, G, wave, lane_, 0); }
        pg8::gemm_phase<EpiRes<0>, pg8::StaticOrder, true, true>(ldsg, g, S, E, wave, wave * 64 + fresh_lane());
    }
    GRID_BAR();

    }
#endif
#if PH & (1<<7)
    for (int rep_ = 0; rep_ < 1 + ((DUP >> 7) & 1); ++rep_) {
    {
        pg8::Gemm g{(const bf16*)(ws + WS_XB), (const bf16*)(ws + WS_WGU), MPROMPT, NGU, D}; pg8::StaticOrder S; S.init(MPROMPT, NGU, G, bx);
        EpiFfnUp E{(const float*)(ws + WS_SS1), (bf16*)(ws + WS_ACT)};
        { int lane_ = fresh_lane(); skinny_gemm<EpiFfnUp, 1024, 1>(lds, g.A, g.Bt, NGU, E, bx, G, wave, lane_, (G == 256) ? 128 : 0); }
        pg8::gemm_phase<EpiFfnUp, pg8::StaticOrder, true, true>(ldsg, g, S, E, wave, wave * 64 + fresh_lane());
        if (G == 256 && bx >= 128) { const int lane_ = fresh_lane(); p0_weights(p, lds, P0_NITEMS - 44 * 32, P0_NITEMS, (bx - 128) * NWAVES + wave, 128 * NWAVES, wave, lane_); }
    }
    GRID_BAR();

    }
#endif
#if PH & (1<<8)
    {
        pg8::Gemm g{(const bf16*)(ws + WS_ACT), (const bf16*)(ws + WS_WD), MPROMPT, D, FF}; pg8::StaticOrder S; S.init(MPROMPT, D, G, bx);
        EpiRes<1> E{p.in[I_XP], p.in[I_XS], p.out, (bf16*)(ws + WS_XB), (float*)(ws + WS_SS2)};
        unsigned* cnt = (unsigned*)(ws + WS_CNT);
        const f32x4* g4 = (const f32x4*)p.in[I_NFG]; const float* ss2 = (const float*)(ws + WS_SS2);
        { int lane_ = fresh_lane(); skinny_gemm<EpiRes<1>, 2816, 4>(lds, g.A, g.Bt, D, E, bx, G, wave, lane_, 0); }
        int m0 = 0, m1 = 0, mstep = 2;
        if (G == 256) {
            asm volatile("s_waitcnt vmcnt(0)" ::: "memory"); __syncthreads();
            if (wave == 0 && fresh_lane() == 0) { __builtin_amdgcn_fence(__ATOMIC_RELEASE, "agent"); asm volatile("s_waitcnt vmcnt(0)" ::: "memory");
                __hip_atomic_fetch_add(cnt, 1u, __ATOMIC_RELAXED, __HIP_MEMORY_SCOPE_AGENT); }
            EpiFinal EF{(const bf16*)(ws + WS_XB), p.out, (float*)(ws + WS_SS2), p.in[I_NFG], cnt};
            pg8::gemm_phase<EpiFinal, pg8::StaticOrder, false, true>(ldsg, g, S, EF, wave, wave * 64 + fresh_lane());
            if (bx < 64) {
                if (wave == 0 && fresh_lane() == 0) { unsigned sp = 0; while (__hip_atomic_load(cnt, __ATOMIC_RELAXED, __HIP_MEMORY_SCOPE_AGENT) < (unsigned)G && ++sp < (1u << 22)) __builtin_amdgcn_s_sleep(2);
                    __builtin_amdgcn_fence(__ATOMIC_ACQUIRE, "agent"); asm volatile("s_waitcnt vmcnt(0)" ::: "memory"); }
                __syncthreads();
                if (wave == 0) { m0 = MPROMPT + 2 * bx; m1 = m0 + 2; }
            }
        } else {
            pg8::gemm_phase<EpiRes<1>, pg8::StaticOrder, true, true>(ldsg, g, S, E, wave, wave * 64 + fresh_lane());
            GRID_BAR();
            m0 = 2 * gw; m1 = MR; mstep = 2 * NGW;
        }
        const int lane = fresh_lane();
        for (int mm = m0; mm < m1; mm += mstep) {
            f32x4 v[2][4]; float rs[2];
#pragma unroll
            for (int r = 0; r < 2; ++r) { rs[r] = ss2[mm + r]; const bf16* xr = (const bf16*)(ws + WS_XB) + (size_t)(mm + r) * D + 4 * lane;
#pragma unroll
                for (int j = 0; j < 4; ++j) v[r][j] = ld_bf4(xr + 256 * j); }
#pragma unroll
            for (int r = 0; r < 2; ++r) { const float rstd = 1.f / sqrtf(rs[r] * (1.f / D) + EPS); f32x4* yr = (f32x4*)(p.out + (size_t)(mm + r) * D) + lane;
#pragma unroll
                for (int j = 0; j < 4; ++j) yr[64 * j] = v[r][j] * rstd * g4[lane + 64 * j]; }
        }
    }
#endif
}

#undef GRID_BAR
extern "C" void kernel_launch(void* const* d_in, const int* in_sizes, int n_in, void* d_out, int out_size, void* d_ws, size_t ws_size, hipStream_t stream) {
    static int grid = 0;
    if (grid == 0) {
        if (n_in != 28 || ws_size < WS_END) { fprintf(stderr, "kernel_launch: unexpected n_in %d / ws_size %zu\n", n_in, ws_size); grid = -1; return; }
        int dev = 0, cus = 0, per_cu = 0;
        hipGetDevice(&dev); hipDeviceGetAttribute(&cus, hipDeviceAttributeMultiprocessorCount, dev);
        if (hipFuncSetAttribute((const void*)mk_fwd, hipFuncAttributeMaxDynamicSharedMemorySize, LDS_BYTES) != hipSuccess) { fprintf(stderr, "kernel_launch: hipFuncSetAttribute failed\n"); grid = -1; return; }
        if (hipOccupancyMaxActiveBlocksPerMultiprocessor(&per_cu, (const void*)mk_fwd, NTHREADS, LDS_BYTES) != hipSuccess || per_cu < 1) { fprintf(stderr, "kernel_launch: occupancy query says %d\n", per_cu); per_cu = 1; }
        (void)hipGetLastError();
        grid = cus * 1;
        fprintf(stderr, "kernel_launch: cus %d per_cu %d grid %d\n", cus, per_cu, grid);
    }
    if (grid < 0) return;
    if (hipMemsetAsync(d_ws, 0, WS_ZERO_BYTES, stream) != hipSuccess) { fprintf(stderr, "kernel_launch: memset failed\n"); return; }
    Params prm{};
    for (int i = 0; i < 28; ++i) prm.in[i] = (const float*)d_in[i];
    prm.out = (float*)d_out; prm.ws = (unsigned char*)d_ws;
    void* args[] = {&prm};
    hipError_t e = hipLaunchCooperativeKernel((const void*)mk_fwd, dim3(grid), dim3(NTHREADS), args, LDS_BYTES, stream);
    if (e != hipSuccess) fprintf(stderr, "cooperative launch failed: %s (grid %d)\n", hipGetErrorString(e), grid);
}
```

```cpp
#include <hip/hip_runtime.h>
#include <hip/hip_cooperative_groups.h>
#include <cstdio>
#include <cstdint>
namespace cg = cooperative_groups;
namespace pg8 {
#define PG8_LAS __attribute__((address_space(3)))
typedef unsigned short bf16_t;
typedef short bf16x8 __attribute__((ext_vector_type(8)));
typedef float f32x4 __attribute__((ext_vector_type(4)));
typedef unsigned u32x4 __attribute__((ext_vector_type(4)));
constexpr int BM = 256, BK = 64, HALF = 128, HTB = HALF * BK * 2  , STAGE_BYTES = 8 * HTB, NXCD = 8, WGM = 8;

__host__ __device__ __forceinline__ int lds_byte(int r, int c) { const int st = (r >> 4) * 2 + (c >> 5), rr = r & 15, cc = c & 31, ob = rr * 64 + cc * 2; return st * 1024 + (ob ^ (((ob >> 9) & 1) << 5)); }
__host__ __device__ __forceinline__ void stage_rc(int b, int& R, int& C) { const int st = b / 1024, sb = b % 1024, swz = sb ^ (((sb >> 9) & 1) << 5); R = (st >> 1) * 16 + swz / 64; C = (st & 1) * 32 + (swz % 64) / 2; }
__host__ __device__ __forceinline__ int perm32(int rho) { const int n = rho >> 4, i = rho & 15; return 8 * (i >> 2) + 4 * n + (i & 3); }

struct Unit { int pm, pn; };
struct Gemm { const bf16_t* A; const bf16_t* Bt; int M, N, K; };

struct StaticOrder {
    int nM, nN, nwg, G, c;
    __host__ __device__ void init(int M, int N, int G_, int c_) { nM = M / BM; nN = N / BM; nwg = nM * nN; G = G_; c = c_; }
    __host__ __device__ bool next(int i, Unit& u) const {
        const long L = (long)i * G + c; if (L >= nwg) return false;
        int wgid = (int)L; { const int q = nwg / NXCD, r = nwg % NXCD, xcd = wgid % NXCD, off = wgid / NXCD; wgid = (xcd < r ? xcd * (q + 1) : r * (q + 1) + (xcd - r) * q) + off; }
        const int nig = WGM * nN, gid = wgid / nig, fm = gid * WGM, gsz = (nM - fm) < WGM ? (nM - fm) : WGM;
        u.pm = fm + ((wgid % nig) % gsz); u.pn = (wgid % nig) / gsz; return true;
    }
    __device__ __forceinline__ void a_ready(const Unit&) const {}
    __device__ __forceinline__ void done(const Unit&) const {}
};
template <class Epi, class Sched, bool ALIGN_EPI = false, bool SP2 = false>
__device__ __forceinline__ void gemm_phase(PG8_LAS unsigned char* lds, const Gemm g, const Sched& S, const Epi& E, const int wid, int tid) {
    asm volatile("" : "+v"(tid));
    const int lane = tid & 63, wr = wid >> 2, wc = wid & 3, fr = lane & 15, fq = lane >> 4;
    const int K = g.K, nt = K / BK;
    unsigned voffA[2], voffB[2];
#pragma unroll
    for (int i = 0; i < 2; ++i) { int R, C; stage_rc(tid * 16 + i * 8192, R, C); const int Rb = Epi::PERM ? ((R & ~31) + perm32(R & 31)) : R;
        voffA[i] = (unsigned)(R * K + C) * 2u; voffB[i] = (unsigned)(Rb * K + C) * 2u; }
    const size_t kstep = (size_t)(BK * 2);
    const size_t hstep = (size_t)HALF * K * 2;
    const size_t tstep = 2 * hstep;
    const unsigned ldsw = (unsigned)wid * 1024u;
    const int aoff = lds_byte(wr * 64 + fr, fq * 8), boff = lds_byte(wc * 32 + fr, fq * 8);
#define PG8_SA(b, h) (((b) * 2 + (h)) * HTB)
#define PG8_SB(b, h) ((4 + (b) * 2 + (h)) * HTB)
#define PG8_STAGE(bufoff, gbase, voff) do { _Pragma("unroll") for (int _i = 0; _i < 2; ++_i) \
        __builtin_amdgcn_global_load_lds((const unsigned*)((const char*)(gbase) + (voff)[_i]), (PG8_LAS unsigned*)(lds + (bufoff) + ldsw + _i * 8192), 16, 0, 0); } while (0)
#define PG8_LDA(dst, b, h) do { _Pragma("unroll") for (int m = 0; m < 4; ++m) _Pragma("unroll") for (int k = 0; k < 2; ++k) dst[m][k] = *(const PG8_LAS bf16x8*)(lds + PG8_SA(b, h) + aoff + m * 2048 + k * 1024); } while (0)
#define PG8_LDB(dst, b, h) do { _Pragma("unroll") for (int n = 0; n < 2; ++n) _Pragma("unroll") for (int k = 0; k < 2; ++k) dst[n][k] = *(const PG8_LAS bf16x8*)(lds + PG8_SB(b, h) + boff + n * 2048 + k * 1024); } while (0)
#define PG8_MMA(ai, bj, At, Bt) do { __builtin_amdgcn_s_setprio(1); _Pragma("unroll") for (int m = 0; m < 4; ++m) _Pragma("unroll") for (int n = 0; n < 2; ++n) _Pragma("unroll") for (int k = 0; k < 2; ++k) \
        acc[ai][bj][m][n] = __builtin_amdgcn_mfma_f32_16x16x32_bf16(Bt[n][k], At[m][k], acc[ai][bj][m][n], 0, 0, 0); __builtin_amdgcn_s_setprio(0); } while (0)
#define PG8_WAIT_V(n) asm volatile("s_waitcnt vmcnt(" #n ")" ::: "memory")
#define PG8_WAIT_L(n) asm volatile("s_waitcnt lgkmcnt(" #n ")" ::: "memory")
#define PG8_BAR __builtin_amdgcn_s_barrier()
#define PG8_SCHED __builtin_amdgcn_sched_barrier(0)
    Unit cur, nxt; int ui = 0;
    if (!S.next(0, cur)) return;
    f32x4 acc[2][2][4][2];
#pragma unroll
    for (int a = 0; a < 2; ++a)
#pragma unroll
        for (int b = 0; b < 2; ++b)
#pragma unroll
            for (int m = 0; m < 4; ++m)
#pragma unroll
                for (int n = 0; n < 2; ++n) acc[a][b][m][n] = (f32x4){0.f, 0.f, 0.f, 0.f};
    bf16x8 At[4][2], B0[2][2], B1[2][2];
    const char* cA = (const char*)g.A + (size_t)cur.pm * tstep; const char* cB = (const char*)g.Bt + (size_t)cur.pn * tstep;
    S.a_ready(cur);
    if constexpr (SP2) {
        PG8_STAGE(PG8_SB(0, 0), cB, voffB); PG8_STAGE(PG8_SB(0, 1), cB + hstep, voffB); PG8_STAGE(PG8_SA(0, 0), cA, voffA); PG8_STAGE(PG8_SA(0, 1), cA + hstep, voffA);
        if (wr == 1) PG8_BAR;
        PG8_WAIT_V(2); PG8_BAR;
        PG8_STAGE(PG8_SB(1, 0), cB + kstep, voffB); PG8_STAGE(PG8_SA(1, 0), cA + kstep, voffA); PG8_STAGE(PG8_SB(1, 1), cB + hstep + kstep, voffB);
        PG8_WAIT_V(6); PG8_BAR;
    } else {
        PG8_STAGE(PG8_SB(0, 0), cB, voffB); PG8_STAGE(PG8_SA(0, 0), cA, voffA); PG8_STAGE(PG8_SB(0, 1), cB + hstep, voffB); PG8_STAGE(PG8_SA(0, 1), cA + hstep, voffA);
        if (wr == 1) PG8_BAR;
        PG8_WAIT_V(4); PG8_BAR;
        PG8_STAGE(PG8_SB(1, 0), cB + kstep, voffB); PG8_STAGE(PG8_SA(1, 0), cA + kstep, voffA); PG8_STAGE(PG8_SB(1, 1), cB + hstep + kstep, voffB);
        PG8_WAIT_V(6); PG8_BAR;
    }
    for (;;) {
        const bool has_next = S.next(ui + 1, nxt);
        const char* nA = has_next ? (const char*)g.A + (size_t)nxt.pm * tstep : cA; const char* nB = has_next ? (const char*)g.Bt + (size_t)nxt.pn * tstep : cB;
        for (int t = 0; t < nt; t += 2) {
            const bool last = (t == nt - 2);
            const char* a1 = cA + (size_t)(t + 1) * kstep;
            const char* a2 = last ? nA : cA + (size_t)(t + 2) * kstep; const char* b2 = last ? nB : cB + (size_t)(t + 2) * kstep;
            const char* a3 = a2 + kstep; const char* b3 = b2 + kstep;
            if (last && has_next) S.a_ready(nxt);
            if constexpr (Epi::HAS_MID) { if (t == (nt >> 1)) E.mid(acc, cur, wr, wc, fr, fq); }
            if constexpr (SP2) {
            PG8_LDB(B0, 0, 0); PG8_LDB(B1, 0, 1); PG8_SCHED; PG8_LDA(At, 0, 0); PG8_STAGE(PG8_SA(1, 1), a1 + hstep, voffA);
            PG8_WAIT_V(8); PG8_WAIT_L(0); PG8_BAR; PG8_MMA(0, 0, At, B0); PG8_MMA(0, 1, At, B1); PG8_BAR; PG8_SCHED;
            PG8_LDA(At, 0, 1); PG8_STAGE(PG8_SB(0, 0), b2, voffB); PG8_STAGE(PG8_SB(0, 1), b2 + hstep, voffB); PG8_STAGE(PG8_SA(0, 0), a2, voffA);
            PG8_WAIT_V(8); PG8_WAIT_L(0); PG8_BAR; PG8_MMA(1, 0, At, B0); PG8_MMA(1, 1, At, B1); PG8_BAR; PG8_SCHED;
            PG8_LDB(B0, 1, 0); PG8_LDB(B1, 1, 1); PG8_SCHED; PG8_LDA(At, 1, 0); PG8_STAGE(PG8_SA(0, 1), a2 + hstep, voffA);
            PG8_WAIT_V(8); PG8_WAIT_L(0); PG8_BAR; PG8_MMA(0, 0, At, B0); PG8_MMA(0, 1, At, B1); PG8_BAR; PG8_SCHED;
            PG8_LDA(At, 1, 1); PG8_STAGE(PG8_SB(1, 0), b3, voffB); PG8_STAGE(PG8_SB(1, 1), b3 + hstep, voffB); PG8_STAGE(PG8_SA(1, 0), a3, voffA);
            PG8_WAIT_V(8); PG8_WAIT_L(0); PG8_BAR; PG8_MMA(1, 0, At, B0); PG8_MMA(1, 1, At, B1); PG8_BAR; PG8_SCHED;
            } else {
            PG8_LDB(B0, 0, 0); PG8_SCHED; PG8_LDA(At, 0, 0); PG8_STAGE(PG8_SA(1, 1), a1 + hstep, voffA);
            PG8_WAIT_L(8); PG8_BAR; PG8_WAIT_L(0); PG8_MMA(0, 0, At, B0); PG8_BAR; PG8_SCHED;
            PG8_LDB(B1, 0, 1); PG8_STAGE(PG8_SB(0, 0), b2, voffB);
            PG8_BAR; PG8_WAIT_L(0); PG8_MMA(0, 1, At, B1); PG8_BAR;
            PG8_LDA(At, 0, 1); PG8_STAGE(PG8_SA(0, 0), a2, voffA);
            PG8_BAR; PG8_WAIT_L(0); PG8_MMA(1, 0, At, B0); PG8_BAR; PG8_SCHED;
            PG8_STAGE(PG8_SB(0, 1), b2 + hstep, voffB);
            PG8_WAIT_V(6); PG8_BAR; PG8_MMA(1, 1, At, B1); PG8_BAR;
            PG8_LDB(B0, 1, 0); PG8_SCHED; PG8_LDA(At, 1, 0); PG8_STAGE(PG8_SA(0, 1), a2 + hstep, voffA);
            PG8_WAIT_L(8); PG8_BAR; PG8_WAIT_L(0); PG8_MMA(0, 0, At, B0); PG8_BAR; PG8_SCHED;
            PG8_LDB(B1, 1, 1); PG8_STAGE(PG8_SB(1, 0), b3, voffB);
            PG8_BAR; PG8_WAIT_L(0); PG8_MMA(0, 1, At, B1); PG8_BAR;
            PG8_LDA(At, 1, 1); PG8_STAGE(PG8_SA(1, 0), a3, voffA);
            PG8_BAR; PG8_WAIT_L(0); PG8_MMA(1, 0, At, B0); PG8_BAR; PG8_SCHED;
            PG8_STAGE(PG8_SB(1, 1), b3 + hstep, voffB);
            PG8_WAIT_V(6); PG8_BAR; PG8_MMA(1, 1, At, B1); PG8_BAR;
            }
        }
        if constexpr (ALIGN_EPI) { if (wr == 0) PG8_BAR; }
        if constexpr (!Epi::AFTER_DRAIN) { E(acc, cur, wr, wc, fr, fq); S.done(cur); }
        if (!has_next) break;
#pragma unroll
        for (int a = 0; a < 2; ++a)
#pragma unroll
            for (int b = 0; b < 2; ++b)
#pragma unroll
                for (int m = 0; m < 4; ++m)
#pragma unroll
                    for (int n = 0; n < 2; ++n) acc[a][b][m][n] = (f32x4){0.f, 0.f, 0.f, 0.f};
        cur = nxt; cA = nA; cB = nB; ++ui;
        if constexpr (ALIGN_EPI) { if (wr == 1) PG8_BAR; }
    }
    PG8_WAIT_V(0);
    if constexpr (!ALIGN_EPI) { if (wr == 0) PG8_BAR; }
    PG8_BAR;
    if constexpr (Epi::AFTER_DRAIN) { E.fused(acc, cur, wr, wc, fr, fq, lds, wid, lane); S.done(cur); }
#undef PG8_SA
#undef PG8_SB
#undef PG8_STAGE
#undef PG8_LDA
#undef PG8_LDB
#undef PG8_MMA
#undef PG8_WAIT_V
#undef PG8_WAIT_L
#undef PG8_BAR
#undef PG8_SCHED
}
}

#define LAS __attribute__((address_space(3)))
typedef unsigned short bf16;
typedef float f32x4 __attribute__((ext_vector_type(4)));
typedef float f32x2 __attribute__((ext_vector_type(2)));
typedef short bf16x8 __attribute__((ext_vector_type(8)));
typedef short bf16x4 __attribute__((ext_vector_type(4)));
typedef unsigned u32x4 __attribute__((ext_vector_type(4)));
typedef unsigned u32x2 __attribute__((ext_vector_type(2)));

constexpr int D = 1024, TPR = 4096, MPROMPT = 16384, NSAMP = 128, MR = 16512, MP = 16640;
constexpr int INW = 3328, FF = 2816, NGU = 5632;
constexpr float EPS = 1e-5f;
constexpr int NSEG = 16;
constexpr int NWAVES = 8, NTHREADS = 512;
constexpr int LDS_BYTES = 135168;

constexpr size_t O_Y = 0, O_KWP = 16908288, O_VWP = 16973824, O_SRP = 17039360, O_SIP = 17047552,
                 O_KWS = 17055744, O_VWS = 19152896, O_SRS = 21250048, O_SIS = 21512192;

constexpr size_t MiB = 1u << 20;
constexpr size_t WS_BAR = 96 * 1024, WS_CNT = 112 * 1024, WS_ZERO_BYTES = 256 * 1024;
constexpr size_t WS_SS1 = 0, WS_SS2 = 128 * 1024, WS_ROPE = 256 * 1024, WS_LBAR = 640 * 1024, WS_LBARS = 656 * 1024,
                 WS_BBM = 672 * 1024, WS_CCM = 800 * 1024, WS_BBF = 1024 * 1024;
constexpr size_t WS_WIN = 2 * MiB, WS_WGLU = 17 * MiB / 2, WS_WBA = 9 * MiB, WS_WBS = 10 * MiB, WS_WOUT = 11 * MiB, WS_WGU = 13 * MiB, WS_WD = 24 * MiB;
constexpr size_t WS_XB = 30 * MiB;
constexpr size_t WS_Q = 63 * MiB;
constexpr size_t WS_K = 80 * MiB, WS_V = 85 * MiB;
constexpr size_t WS_U = 90 * MiB;
constexpr size_t WS_G = 107 * MiB;
constexpr size_t WS_Z = 172 * MiB;
constexpr size_t WS_M = 189 * MiB;
constexpr size_t WS_E = 222 * MiB;
constexpr size_t WS_ACT = 63 * MiB;
constexpr size_t WS_AS = 223 * MiB;
constexpr size_t WS_END = 256 * MiB;
static_assert(WS_AS + (size_t)MP * D * 2 <= WS_END, "AS map");
static_assert(WS_ACT + (size_t)MP * FF * 2 <= WS_Z, "act overlay");
static_assert(WS_WIN + (size_t)INW * D * 2 <= WS_WGLU && WS_WGU + (size_t)NGU * D * 2 <= WS_WD && WS_WD + (size_t)D * FF * 2 <= WS_XB, "weights map");
static_assert(WS_XB + (size_t)MP * D * 2 <= WS_Q && WS_Q + (size_t)MP * 512 * 2 <= WS_K && WS_G + (size_t)MP * 2048 * 2 <= WS_Z && WS_M + (size_t)MP * D * 2 <= WS_E, "act map");

struct Params { const float* in[28]; float* out; unsigned char* ws; };

enum { I_XP = 0, I_XS, I_SK, I_SV, I_SRE, I_SIM, I_N1G, I_WIN, I_BG, I_SINK, I_LRE, I_LIM, I_LDT, I_BRE, I_BIM, I_CRE, I_CIM, I_SD, I_WGLU, I_BGLU,
       I_WBA, I_WBS, I_WOUT, I_N2G, I_WFG, I_WFU, I_WFD, I_NFG };

#define LDS_WAIT() asm volatile("s_waitcnt lgkmcnt(0)" ::: "memory")
__device__ __forceinline__ unsigned f2bf(float f) { unsigned u = __builtin_bit_cast(unsigned, f); return (u + 0x7fffu + ((u >> 16) & 1u)) >> 16; }
__device__ __forceinline__ unsigned pk2(float lo, float hi) { unsigned r; asm("v_cvt_pk_bf16_f32 %0, %1, %2" : "=v"(r) : "v"(lo), "v"(hi)); return r; }
__device__ __forceinline__ float bflo(unsigned w) { return __builtin_bit_cast(float, w << 16); }
__device__ __forceinline__ float bfhi(unsigned w) { return __builtin_bit_cast(float, w & 0xffff0000u); }
__device__ __forceinline__ float bf2f(unsigned short b) { return __builtin_bit_cast(float, (unsigned)b << 16); }
__device__ __forceinline__ f32x4 ld_bf4(const bf16* p) { const u32x2 w = *(const u32x2*)p; return (f32x4){bflo(w.x), bfhi(w.x), bflo(w.y), bfhi(w.y)}; }
__device__ __forceinline__ void st_bf4(bf16* p, f32x4 v) { u32x2 w; w.x = pk2(v[0], v[1]); w.y = pk2(v[2], v[3]); *(u32x2*)p = w; }
__device__ __forceinline__ void ld_bf8(const bf16* p, f32x4& a, f32x4& b) { const u32x4 w = *(const u32x4*)p; a = (f32x4){bflo(w.x), bfhi(w.x), bflo(w.y), bfhi(w.y)}; b = (f32x4){bflo(w.z), bfhi(w.z), bflo(w.w), bfhi(w.w)}; }
__device__ __forceinline__ void st_bf8(bf16* p, f32x4 a, f32x4 b) { u32x4 w; w.x = pk2(a[0], a[1]); w.y = pk2(a[2], a[3]); w.z = pk2(b[0], b[1]); w.w = pk2(b[2], b[3]); *(u32x4*)p = w; }
__device__ __forceinline__ float sigm(float x) { return __builtin_amdgcn_rcpf(1.f + __expf(-x)); }
__device__ __forceinline__ float gelu_tanh(float x) { const float t = 1.5957691216057308f * (x + 0.044715f * x * x * x); return x * __builtin_amdgcn_rcpf(1.f + __expf(-t)); }
__device__ __forceinline__ float wave_sum(float v) {
#pragma unroll
    for (int o = 1; o < 64; o <<= 1) v += __shfl_xor(v, o);
    return v;
}
__device__ __forceinline__ float wave_max(float v) {
#pragma unroll
    for (int o = 1; o < 64; o <<= 1) v = fmaxf(v, __shfl_xor(v, o));
    return v;
}

__device__ __forceinline__ int fresh_lane() { int l = (int)__builtin_amdgcn_mbcnt_hi(~0u, __builtin_amdgcn_mbcnt_lo(~0u, 0u)); asm volatile("" : "+v"(l)); return l; }

__device__ __forceinline__ void p0_transpose_item(const float* W, int K, int N, bf16* WT, int mode, const float* gk, float* scr, int item, int lane, int ldk = 0, int koff = 0) {
    if (ldk == 0) ldk = K;
    const int nblk = N / 32, kb = item / nblk, nb = item % nblk, k0 = 64 * kb, n0 = 32 * nb;
    float tv[32];
#pragma unroll
    for (int i = 0; i < 32; ++i) { const int kk = 2 * i + (lane >> 5); tv[i] = W[(size_t)(k0 + kk) * N + n0 + (lane & 31)]; }
    if (gk) {
#pragma unroll
        for (int i = 0; i < 32; ++i) tv[i] *= gk[k0 + 2 * i + (lane >> 5)];
    }
#pragma unroll
    for (int i = 0; i < 32; ++i) scr[(2 * i + (lane >> 5)) * 33 + (lane & 31)] = tv[i];
    LDS_WAIT();
    const int c = lane & 7;
#pragma unroll
    for (int j = 0; j < 4; ++j) { const int n = (lane >> 3) + 8 * j; const float* s = scr + (8 * c) * 33 + n;
        u32x4 o; o.x = pk2(s[0 * 33], s[1 * 33]); o.y = pk2(s[2 * 33], s[3 * 33]); o.z = pk2(s[4 * 33], s[5 * 33]); o.w = pk2(s[6 * 33], s[7 * 33]);
        const int nn = n0 + n; const int row = (mode == 0) ? nn : (((nn >> 7) << 8) + (mode == 2 ? 128 : 0) + (nn & 127));
        *(u32x4*)(WT + (size_t)row * ldk + koff + k0 + 8 * c) = o; }
    LDS_WAIT();
}

constexpr int P0_I0 = 16 * 104, P0_NITEMS = 16 * 104 + 8 * 16 + 8 * 32 + 8 * 32 + 16 * 32 + 16 * 88 + 16 * 88 + 44 * 32;
__device__ __forceinline__ void p0_weights(const Params& p, unsigned char* lds, int it0, int it1, int gw, int NGW, int wave, int lane) {
    unsigned char* ws = p.ws;
    float* scr = (float*)(lds + wave * 16384);
    constexpr int I0 = 16 * 104, I1 = 8 * 16, I2 = 8 * 32, I3 = 8 * 32, I4 = 16 * 32, I5 = 16 * 88, I6 = 16 * 88;
    for (int it = it0 + gw; it < it1; it += NGW) {
        int r = it;
        if (r < I0) { p0_transpose_item(p.in[I_WIN], 1024, INW, (bf16*)(ws + WS_WIN), 0, nullptr, scr, r, lane); continue; } r -= I0;
        if (r < I1) { p0_transpose_item(p.in[I_WGLU], 512, 512, (bf16*)(ws + WS_WGLU), 0, nullptr, scr, r, lane); continue; } r -= I1;
        if (r < I2) { p0_transpose_item(p.in[I_WBA], 512, 1024, (bf16*)(ws + WS_WBA), 0, nullptr, scr, r, lane, 1024, 0); continue; } r -= I2;
        if (r < I3) { p0_transpose_item(p.in[I_WBS], 512, 1024, (bf16*)(ws + WS_WBA), 0, nullptr, scr, r, lane, 1024, 512); continue; } r -= I3;
        if (r < I4) { p0_transpose_item(p.in[I_WOUT], 1024, 1024, (bf16*)(ws + WS_WOUT), 0, nullptr, scr, r, lane); continue; } r -= I4;
        if (r < I5) { p0_transpose_item(p.in[I_WFG], 1024, FF, (bf16*)(ws + WS_WGU), 1, p.in[I_N2G], scr, r, lane); continue; } r -= I5;
        if (r < I6) { p0_transpose_item(p.in[I_WFU], 1024, FF, (bf16*)(ws + WS_WGU), 2, p.in[I_N2G], scr, r, lane); continue; } r -= I6;
        p0_transpose_item(p.in[I_WFD], FF, 1024, (bf16*)(ws + WS_WD), 0, nullptr, scr, r, lane);
    }
}

__device__ __forceinline__ void p0_prologue(const Params& p, unsigned char* lds, int gw, int NGW, int wave, int lane) {
    unsigned char* ws = p.ws;
    bf16* xb = (bf16*)(ws + WS_XB);
    const f32x4* g4 = (const f32x4*)p.in[I_N1G];
    for (int m0 = 2 * gw; m0 < MR; m0 += 2 * NGW) {
        f32x4 v[2][4]; float s[2] = {0.f, 0.f};
#pragma unroll
        for (int r = 0; r < 2; ++r) {
            const int m = m0 + r;
            const float* xrow = (m < MPROMPT) ? p.in[I_XP] + (size_t)m * D : p.in[I_XS] + (size_t)(m - MPROMPT) * D;
            const f32x4* xr = (const f32x4*)xrow + 2 * lane;
#pragma unroll
            for (int j = 0; j < 2; ++j) { v[r][2 * j] = xr[128 * j]; v[r][2 * j + 1] = xr[128 * j + 1]; }
        }
#pragma unroll
        for (int r = 0; r < 2; ++r) {
#pragma unroll
            for (int j = 0; j < 4; ++j) s[r] += (v[r][j].x * v[r][j].x + v[r][j].y * v[r][j].y) + (v[r][j].z * v[r][j].z + v[r][j].w * v[r][j].w);
        }
#pragma unroll
        for (int r = 0; r < 2; ++r) {
            const int m = m0 + r;
            const float rstd = 1.f / sqrtf(wave_sum(s[r]) * (1.f / D) + EPS);
#pragma unroll
            for (int j = 0; j < 2; ++j) { const f32x4 ga = g4[2 * lane + 128 * j], gb = g4[2 * lane + 128 * j + 1];
                st_bf8(xb + (size_t)m * D + 8 * lane + 512 * j, v[r][2 * j] * rstd * ga, v[r][2 * j + 1] * rstd * gb); }
        }
    }
    const int gt = gw * 64 + lane, NGT = NGW * 64;
    for (int i = gt; i < 4097 * 8; i += NGT) {
        const int pi = i >> 3, fi = i & 7; const double pos = (pi == 4096) ? 8192.0 : (double)pi;
        const double invf[8] = {1.0, 0.19392274474868576, 0.03760603093086393, 0.007292664737217109, 0.001414213562373095, 0.0002742481756762073, 5.318295896944988e-05, 1.031338537721246e-05};
        double fsel = invf[0];
#pragma unroll
        for (int q = 1; q < 8; ++q) fsel = (fi == q) ? invf[q] : fsel;
        const double rev = pos * fsel * 0.15915494309189535; const double fr = rev - __builtin_rint(rev);
        const float a = (float)(fr * 6.283185307179586);
        ((f32x2*)(ws + WS_ROPE))[i] = (f32x2){cosf(a), sinf(a)};
    }
    for (int i = gw; i < 32 * 64; i += NGW) {
        const int g = i >> 6, pp = i & 63;
        const double dt = exp((double)p.in[I_LDT][g]); const double lr = (double)p.in[I_LRE][i], li = (double)p.in[I_LIM][i];
        const double mag = exp(lr * dt); double ang = li * dt; { const double rv = ang * 0.15915494309189535; ang = (rv - __builtin_rint(rv)) * 6.283185307179586; }
        const double lbr = mag * (double)cosf((float)ang), lbi = mag * (double)sinf((float)ang);
        if (lane == 0) ((f32x2*)(ws + WS_LBAR))[i] = (f32x2){(float)lbr, (float)lbi};
        if (lane == 0) { const double mS = exp(lr * dt * 256.0); double aS = li * dt * 256.0; const double rv = aS * 0.15915494309189535; aS = (rv - __builtin_rint(rv)) * 6.283185307179586;
          ((f32x2*)(ws + WS_LBARS))[i] = (f32x2){(float)(mS * (double)cosf((float)aS)), (float)(mS * (double)sinf((float)aS))}; }
        const double den = lr * lr + li * li, nr = lbr - 1.0;
        const float cr = (float)((nr * lr + lbi * li) / den), ci = (float)((lbi * lr - nr * li) / den);
        bf16* bbm = (bf16*)(ws + WS_BBM); f32x2* bbf = (f32x2*)(ws + WS_BBF); bf16* ccm = (bf16*)(ws + WS_CCM);
        if (lane < 16) { const int h = lane;
            const float br = p.in[I_BRE][i * 16 + h], bi = p.in[I_BIM][i * 16 + h];
            const float xr = cr * br - ci * bi, xi = cr * bi + ci * br;
            bbf[i * 16 + h] = (f32x2){xr, xi};
            bbm[(g * 128 + pp) * 16 + h] = (bf16)f2bf(xr); bbm[(g * 128 + 64 + pp) * 16 + h] = (bf16)f2bf(xi);
            const float c_r = p.in[I_CRE][(g * 16 + h) * 64 + pp], c_i = p.in[I_CIM][(g * 16 + h) * 64 + pp];
            ((unsigned*)ccm)[((g * 16 + h) * 128 + 2 * pp) >> 1] = pk2(c_r, -c_i);
        }
    }
}

struct EpiIn {
    static constexpr bool PERM = true, AFTER_DRAIN = false, HAS_MID = false, KHALVES = false; static constexpr int NF = 1;
    unsigned char* ws; const float* bgate; int cb0;
    __device__ __forceinline__ f32x4 do_rope(f32x4 x, int row, int fq) const {
        const int posidx = (row < MPROMPT) ? (row & 4095) : 4096;
        const f32x2* rp = (const f32x2*)(ws + WS_ROPE) + posidx * 8 + 4 * (fq & 1);
        f32x4 o;
#pragma unroll
        for (int e = 0; e < 4; ++e) { const float pv = __shfl_xor(x[e], 32); const f32x2 cs = rp[e]; o[e] = (fq < 2) ? (x[e] * cs.x - pv * cs.y) : (x[e] * cs.x + pv * cs.y); }
        return o;
    }
    __device__ __forceinline__ void elem(int row, int cb, int cl, f32x4 x, int fq, bool rope_frag) const {
        if (cb < 4) {
            if (rope_frag) x = do_rope(x, row, fq);
            st_bf4((bf16*)(ws + WS_Q) + (size_t)row * 512 + cb * 128 + cl, x * 0.125f);
        } else if (cb < 6) {
            if (cb == 4 && rope_frag) x = do_rope(x, row, fq);
            st_bf4((bf16*)(ws + (cb == 4 ? WS_K : WS_V)) + (size_t)row * 128 + cl, x);
        } else if (cb < 10) {
            st_bf4((bf16*)(ws + WS_U) + (size_t)row * 512 + (cb - 6) * 128 + cl, x);
        } else {
            const int c = (cb - 10) * 128 + cl; const f32x4 b = *(const f32x4*)(bgate + c);
            st_bf4((bf16*)(ws + WS_G) + (size_t)row * 2048 + c, (f32x4){sigm(x[0] + b[0]), sigm(x[1] + b[1]), sigm(x[2] + b[2]), sigm(x[3] + b[3])});
        }
    }
    __device__ __forceinline__ void rope8(f32x4& x0, f32x4& x1, int row, int fq) const {
        const int posidx = (row < MPROMPT) ? (row & 4095) : 4096;
        const f32x4* rp = (const f32x4*)((const f32x2*)(ws + WS_ROPE) + posidx * 8);
        const f32x4 c01 = rp[0], c23 = rp[1], c45 = rp[2], c67 = rp[3];
        const float cs[8] = {c01[0], c23[0], c45[0], c67[0], c01[2], c23[2], c45[2], c67[2]};
        const float sn[8] = {c01[1], c23[1], c45[1], c67[1], c01[3], c23[3], c45[3], c67[3]};
        const float sg = (fq == 0) ? -1.f : 1.f;
#pragma unroll
        for (int e = 0; e < 4; ++e) {
            const float p0 = __shfl_xor(x0[e], 16), p1 = __shfl_xor(x1[e], 16);
            const float r0 = x0[e] * (e == 0 ? c01[0] : e == 1 ? c01[2] : e == 2 ? c23[0] : c23[2]) + sg * p0 * (e == 0 ? c01[1] : e == 1 ? c01[3] : e == 2 ? c23[1] : c23[3]);
            const float r1 = x1[e] * (e == 0 ? c45[0] : e == 1 ? c45[2] : e == 2 ? c67[0] : c67[2]) + sg * p1 * (e == 0 ? c45[1] : e == 1 ? c45[3] : e == 2 ? c67[1] : c67[3]);
            x0[e] = (fq < 2) ? r0 : x0[e]; x1[e] = (fq < 2) ? r1 : x1[e];
        }
        (void)cs; (void)sn;
    }
    __device__ __forceinline__ void operator()(const f32x4 (&acc)[2][2][4][2], const pg8::Unit& un, int wr, int wc, int fr, int fq) const {
#pragma unroll
        for (int bj = 0; bj < 2; ++bj) {
            const int cb = cb0 + 2 * un.pn + bj;
            const int cl = 32 * wc + 8 * fq;
            f32x4 b0 = (f32x4){0.f, 0.f, 0.f, 0.f}, b1 = b0;
            if (cb >= 10) { b0 = *(const f32x4*)(bgate + (cb - 10) * 128 + cl); b1 = *(const f32x4*)(bgate + (cb - 10) * 128 + cl + 4); }
#pragma unroll
            for (int ai = 0; ai < 2; ++ai)
#pragma unroll
                for (int m = 0; m < 4; ++m) {
                    const int row = un.pm * 256 + ai * 128 + wr * 64 + m * 16 + fr;
                    f32x4 x0 = acc[ai][bj][m][0], x1 = acc[ai][bj][m][1];
                    if (cb < 4) {
                        if ((wc & 1) == 0) rope8(x0, x1, row, fq);
                        st_bf8((bf16*)(ws + WS_Q) + (size_t)row * 512 + cb * 128 + cl, x0 * 0.125f, x1 * 0.125f);
                    } else if (cb < 6) {
                        if (cb == 4 && (wc & 1) == 0) rope8(x0, x1, row, fq);
                        st_bf8((bf16*)(ws + (cb == 4 ? WS_K : WS_V)) + (size_t)row * 128 + cl, x0, x1);
                    } else if (cb < 10) {
                        st_bf8((bf16*)(ws + WS_U) + (size_t)row * 512 + (cb - 6) * 128 + cl, x0, x1);
                    } else {
                        const int c = (cb - 10) * 128 + cl;
                        st_bf8((bf16*)(ws + WS_G) + (size_t)row * 2048 + c, (f32x4){sigm(x0[0] + b0[0]), sigm(x0[1] + b0[1]), sigm(x0[2] + b0[2]), sigm(x0[3] + b0[3])},
                               (f32x4){sigm(x1[0] + b1[0]), sigm(x1[1] + b1[1]), sigm(x1[2] + b1[2]), sigm(x1[3] + b1[3])});
                    }
                }
        }
    }
    __device__ __forceinline__ void skinny(const f32x4 (&x)[1], int row, int n0, int fq) const { elem(row, cb0 + (n0 >> 7), (n0 & 127) + 4 * fq, x[0], fq, (n0 & 63) == 0); }
};

struct EpiGlu {
    static constexpr bool PERM = true, AFTER_DRAIN = false, HAS_MID = false, KHALVES = false; static constexpr int NF = 1;
    const bf16* z; bf16* so; const float* b;
    __device__ __forceinline__ void elem(int row, int c, f32x4 x) const {
        const f32x4 bb = *(const f32x4*)(b + c), zz = ld_bf4(z + (size_t)row * 512 + c);
        st_bf4(so + (size_t)row * 1024 + 512 + c, (f32x4){zz[0] * sigm(x[0] + bb[0]), zz[1] * sigm(x[1] + bb[1]), zz[2] * sigm(x[2] + bb[2]), zz[3] * sigm(x[3] + bb[3])});
    }
    __device__ __forceinline__ void operator()(const f32x4 (&acc)[2][2][4][2], const pg8::Unit& un, int wr, int wc, int fr, int fq) const {
#pragma unroll
        for (int ai = 0; ai < 2; ++ai)
#pragma unroll
            for (int m = 0; m < 4; ++m) {
                const int row = un.pm * 256 + ai * 128 + wr * 64 + m * 16 + fr;
#pragma unroll
                for (int bj = 0; bj < 2; ++bj) {
                    const int c = un.pn * 256 + bj * 128 + 32 * wc + 8 * fq;
                    const f32x4 x0 = acc[ai][bj][m][0], x1 = acc[ai][bj][m][1], b0 = *(const f32x4*)(b + c), b1 = *(const f32x4*)(b + c + 4);
                    f32x4 z0, z1; ld_bf8(z + (size_t)row * 512 + c, z0, z1);
                    st_bf8(so + (size_t)row * 1024 + 512 + c, (f32x4){z0[0] * sigm(x0[0] + b0[0]), z0[1] * sigm(x0[1] + b0[1]), z0[2] * sigm(x0[2] + b0[2]), z0[3] * sigm(x0[3] + b0[3])},
                           (f32x4){z1[0] * sigm(x1[0] + b1[0]), z1[1] * sigm(x1[1] + b1[1]), z1[2] * sigm(x1[2] + b1[2]), z1[3] * sigm(x1[3] + b1[3])});
                }
            }
    }
    __device__ __forceinline__ void skinny(const f32x4 (&x)[1], int row, int n0, int fq) const { elem(row, n0 + 4 * fq, x[0]); }
};

struct EpiMerge {
    static constexpr bool PERM = true, AFTER_DRAIN = false, HAS_MID = true, KHALVES = true; static constexpr int NF = 1;
    const bf16* g; bf16* mo;
    __device__ __forceinline__ void mid(f32x4 (&acc)[2][2][4][2], const pg8::Unit& un, int wr, int wc, int fr, int fq) const {
#pragma unroll
        for (int ai = 0; ai < 2; ++ai)
#pragma unroll
            for (int mp = 0; mp < 2; ++mp) {
                asm volatile("" ::: "memory");
                u32x4 w1[2][2], w2[2][2];
#pragma unroll
                for (int mm = 0; mm < 2; ++mm) {
                    const int row = un.pm * 256 + ai * 128 + wr * 64 + (2 * mp + mm) * 16 + fr;
#pragma unroll
                    for (int bj = 0; bj < 2; ++bj) {
                        const int c = un.pn * 256 + bj * 128 + 32 * wc + 8 * fq;
                        w1[mm][bj] = *(const u32x4*)(g + (size_t)row * 2048 + c); w2[mm][bj] = *(const u32x4*)(g + (size_t)row * 2048 + 1024 + c);
                    }
                }
#pragma unroll
                for (int mm = 0; mm < 2; ++mm)
#pragma unroll
                    for (int bj = 0; bj < 2; ++bj) {
                        const u32x4 a = w1[mm][bj], q = w2[mm][bj]; const int m = 2 * mp + mm;
                        const f32x4 p0 = (f32x4){bflo(a.x), bfhi(a.x), bflo(a.y), bfhi(a.y)}, p1 = (f32x4){bflo(a.z), bfhi(a.z), bflo(a.w), bfhi(a.w)};
                        const f32x4 q0 = (f32x4){bflo(q.x), bfhi(q.x), bflo(q.y), bfhi(q.y)}, q1 = (f32x4){bflo(q.z), bfhi(q.z), bflo(q.w), bfhi(q.w)};
                        f32x4 r0, r1;
#pragma unroll
                        for (int e = 0; e < 4; ++e) { r0[e] = p0[e] * __builtin_amdgcn_rcpf(q0[e]); r1[e] = p1[e] * __builtin_amdgcn_rcpf(q1[e]); }
                        acc[ai][bj][m][0] = acc[ai][bj][m][0] * r0; acc[ai][bj][m][1] = acc[ai][bj][m][1] * r1;
                    }
            }
    }
    __device__ __forceinline__ void operator()(const f32x4 (&acc)[2][2][4][2], const pg8::Unit& un, int wr, int wc, int fr, int fq) const {
#pragma unroll
        for (int ai = 0; ai < 2; ++ai)
#pragma unroll
            for (int m = 0; m < 4; ++m) {
                const int row = un.pm * 256 + ai * 128 + wr * 64 + m * 16 + fr;
#pragma unroll
                for (int bj = 0; bj < 2; ++bj) {
                    const int c = un.pn * 256 + bj * 128 + 32 * wc + 8 * fq;
                    f32x4 q0, q1; ld_bf8(g + (size_t)row * 2048 + 1024 + c, q0, q1);
                    st_bf8(mo + (size_t)row * D + c, acc[ai][bj][m][0] * q0, acc[ai][bj][m][1] * q1);
                }
            }
    }
    __device__ __forceinline__ void skinny(const f32x4 (&x)[2], int row, int n0, int fq) const {
        const int c = n0 + 4 * fq;
        st_bf4(mo + (size_t)row * D + c, x[0] * ld_bf4(g + (size_t)row * 2048 + c) + x[1] * ld_bf4(g + (size_t)row * 2048 + 1024 + c));
    }
};

template <int STEP> struct EpiRes {
    static constexpr bool PERM = (STEP == 0), AFTER_DRAIN = false, HAS_MID = false, KHALVES = false; static constexpr int NF = 1;
    const float *xp, *xs; float* out; bf16* xb; float* ss;
    __device__ __forceinline__ float elem(int row, int c, f32x4 x) const {
        if (STEP == 0) {
            const f32x4 r = (row < MPROMPT) ? *(const f32x4*)(xp + (size_t)row * D + c) : *(const f32x4*)(xs + (size_t)(row - MPROMPT) * D + c);
            x = x + r;
            st_bf4(xb + (size_t)row * D + c, x);
        } else {
            x = x + ld_bf4(xb + (size_t)row * D + c); st_bf4(xb + (size_t)row * D + c, x);
        }
        return (x[0] * x[0] + x[1] * x[1]) + (x[2] * x[2] + x[3] * x[3]);
    }
    __device__ __forceinline__ void operator()(const f32x4 (&acc)[2][2][4][2], const pg8::Unit& un, int wr, int wc, int fr, int fq) const {
#pragma unroll
        for (int ai = 0; ai < 2; ++ai)
#pragma unroll
            for (int m = 0; m < 4; ++m) {
                const int row = un.pm * 256 + ai * 128 + wr * 64 + m * 16 + fr;
                float s = 0.f;
                if constexpr (STEP == 0) {
#pragma unroll
                    for (int bj = 0; bj < 2; ++bj) {
                        const int c = un.pn * 256 + bj * 128 + 32 * wc + 8 * fq;
                        const float* xr = (row < MPROMPT) ? xp + (size_t)row * D + c : xs + (size_t)(row - MPROMPT) * D + c;
                        const f32x4 x0 = acc[ai][bj][m][0] + *(const f32x4*)xr, x1 = acc[ai][bj][m][1] + *(const f32x4*)(xr + 4);
                        st_bf8(xb + (size_t)row * D + c, x0, x1);
                        s += ((x0[0] * x0[0] + x0[1] * x0[1]) + (x0[2] * x0[2] + x0[3] * x0[3])) + ((x1[0] * x1[0] + x1[1] * x1[1]) + (x1[2] * x1[2] + x1[3] * x1[3]));
                    }
                } else {
#pragma unroll
                    for (int bj = 0; bj < 2; ++bj)
#pragma unroll
                        for (int n = 0; n < 2; ++n) s += elem(row, un.pn * 256 + bj * 128 + 32 * wc + 16 * n + 4 * fq, acc[ai][bj][m][n]);
                }
                s += __shfl_xor(s, 16); s += __shfl_xor(s, 32);
                if (fq == 0) atomicAdd(ss + row, s);
            }
    }
    __device__ __forceinline__ void skinny(const f32x4 (&x)[1], int row, int n0, int fq) const {
        float s = elem(row, n0 + 4 * fq, x[0]);
        s += __shfl_xor(s, 16); s += __shfl_xor(s, 32);
        if (fq == 0) atomicAdd(ss + row, s);
    }
};

struct EpiFinal {
    static constexpr bool PERM = true, AFTER_DRAIN = true, HAS_MID = false, KHALVES = false; static constexpr int NF = 1;
    const bf16* xb; float* out; float* ss; const float* gf; unsigned* cnt;
    __device__ __forceinline__ void operator()(const f32x4 (&)[2][2][4][2], const pg8::Unit&, int, int, int, int) const {}
    __device__ __forceinline__ void fused(f32x4 (&acc)[2][2][4][2], const pg8::Unit& un, int wr, int wc, int fr, int fq, PG8_LAS unsigned char*, int wid, int lane) const {
#pragma unroll
        for (int ai = 0; ai < 2; ++ai)
#pragma unroll
            for (int m = 0; m < 4; ++m) {
                const int row = un.pm * 256 + ai * 128 + wr * 64 + m * 16 + fr;
                float s = 0.f;
#pragma unroll
                for (int bj = 0; bj < 2; ++bj) {
                    const int c = un.pn * 256 + bj * 128 + 32 * wc + 8 * fq;
                    f32x4 r0, r1; ld_bf8(xb + (size_t)row * D + c, r0, r1);
                    const f32x4 x0 = acc[ai][bj][m][0] + r0, x1 = acc[ai][bj][m][1] + r1;
                    acc[ai][bj][m][0] = x0; acc[ai][bj][m][1] = x1;
                    s += ((x0[0] * x0[0] + x0[1] * x0[1]) + (x0[2] * x0[2] + x0[3] * x0[3])) + ((x1[0] * x1[0] + x1[1] * x1[1]) + (x1[2] * x1[2] + x1[3] * x1[3]));
                }
                s += __shfl_xor(s, 16); s += __shfl_xor(s, 32);
                if (fq == 0) atomicAdd(ss + row, s);
            }
        asm volatile("s_waitcnt vmcnt(0)" ::: "memory"); __syncthreads();
        if (wid == 0 && lane == 0) {
            __builtin_amdgcn_fence(__ATOMIC_RELEASE, "agent"); asm volatile("s_waitcnt vmcnt(0)" ::: "memory");
            __hip_atomic_fetch_add(cnt + 256 + 16 * un.pm, 1u, __ATOMIC_RELAXED, __HIP_MEMORY_SCOPE_AGENT);
            unsigned sp = 0;
            while (__hip_atomic_load(cnt + 256 + 16 * un.pm, __ATOMIC_RELAXED, __HIP_MEMORY_SCOPE_AGENT) < 4u && ++sp < (1u << 22)) __builtin_amdgcn_s_sleep(2);
            __builtin_amdgcn_fence(__ATOMIC_ACQUIRE, "agent"); asm volatile("s_waitcnt vmcnt(0)" ::: "memory");
        }
        __syncthreads();
#pragma unroll
        for (int ai = 0; ai < 2; ++ai)
#pragma unroll
            for (int m = 0; m < 4; ++m) {
                const int row = un.pm * 256 + ai * 128 + wr * 64 + m * 16 + fr;
                const float rstd = 1.f / sqrtf(__hip_atomic_load(ss + row, __ATOMIC_RELAXED, __HIP_MEMORY_SCOPE_AGENT) * (1.f / D) + EPS);
#pragma unroll
                for (int bj = 0; bj < 2; ++bj) {
                    const int c = un.pn * 256 + bj * 128 + 32 * wc + 8 * fq;
                    *(f32x4*)(out + (size_t)row * D + c) = acc[ai][bj][m][0] * rstd * *(const f32x4*)(gf + c);
                    *(f32x4*)(out + (size_t)row * D + c + 4) = acc[ai][bj][m][1] * rstd * *(const f32x4*)(gf + c + 4);
                }
            }
    }
};

struct EpiFfnUp {
    static constexpr bool PERM = true, AFTER_DRAIN = false, HAS_MID = false, KHALVES = false; static constexpr int NF = 2;
    const float* ss; bf16* act;
    __device__ __forceinline__ void elem(int row, int j, f32x4 gt, f32x4 up, float rstd) const {
        gt = gt * rstd; up = up * rstd;
        st_bf4(act + (size_t)row * FF + j, (f32x4){gt[0] * sigm(gt[0]) * up[0], gt[1] * sigm(gt[1]) * up[1], gt[2] * sigm(gt[2]) * up[2], gt[3] * sigm(gt[3]) * up[3]});
    }
    __device__ __forceinline__ void operator()(const f32x4 (&acc)[2][2][4][2], const pg8::Unit& un, int wr, int wc, int fr, int fq) const {
#pragma unroll
        for (int ai = 0; ai < 2; ++ai)
#pragma unroll
            for (int m = 0; m < 4; ++m) {
                const int row = un.pm * 256 + ai * 128 + wr * 64 + m * 16 + fr;
                const float rstd = 1.f / sqrtf(ss[row] * (1.f / D) + EPS);
                const int j = 128 * un.pn + 32 * wc + 8 * fq;
                const f32x4 g0 = acc[ai][0][m][0] * rstd, g1 = acc[ai][0][m][1] * rstd, u0 = acc[ai][1][m][0] * rstd, u1 = acc[ai][1][m][1] * rstd;
                st_bf8(act + (size_t)row * FF + j, (f32x4){g0[0] * sigm(g0[0]) * u0[0], g0[1] * sigm(g0[1]) * u0[1], g0[2] * sigm(g0[2]) * u0[2], g0[3] * sigm(g0[3]) * u0[3]},
                       (f32x4){g1[0] * sigm(g1[0]) * u1[0], g1[1] * sigm(g1[1]) * u1[1], g1[2] * sigm(g1[2]) * u1[2], g1[3] * sigm(g1[3]) * u1[3]});
            }
    }
    __device__ __forceinline__ void skinny(const f32x4 (&x)[2], int row, int j0, int fq) const {
        elem(row, j0 + 4 * fq, x[0], x[1], 1.f / sqrtf(ss[row] * (1.f / D) + EPS));
    }
};

template <class Epi, int K, int MQ> __device__ __forceinline__ void skinny_gemm(unsigned char* lds, const bf16* A, const bf16* Bt, int N, const Epi& E, int bx, int G, int wave, int lane, int lo) {
    constexpr int NF = Epi::NF, MFR = 8 / MQ, KS = K / 8, NSTEP = KS / 32;
    static_assert(KS % 32 == 0, "K slice per wave must be a multiple of 32");
    const int NP = (N / (16 * NF)) * MQ;
    if (bx < lo) return;
    const int fr = lane & 15, fq = lane >> 4;
    f32x4* red = (f32x4*)lds;
    for (int pc = G - 1 - bx; pc < NP; pc += G - lo) {
        const int mq = pc % MQ, pq = pc / MQ, r0 = MPROMPT + mq * 16 * MFR;
        const int n0 = (NF == 2) ? ((pq >> 3) * 256 + (pq & 7) * 16) : pq * 16;
        const int ncol = (NF == 2) ? pq * 16 : n0;
        const bf16* ap = A + (size_t)(r0 + fr) * K + wave * KS + 8 * fq;
        const bf16* bp = Bt + (size_t)(n0 + fr) * K + wave * KS + 8 * fq;
        bf16x8 bfr[NSTEP][NF], afr[NSTEP][MFR];
#pragma unroll
        for (int st = 0; st < NSTEP; ++st) {
#pragma unroll
            for (int nf = 0; nf < NF; ++nf) bfr[st][nf] = *(const bf16x8*)(bp + (size_t)((NF == 2 ? 128 : 16) * nf) * K + 32 * st);
#pragma unroll
            for (int mf = 0; mf < MFR; ++mf) afr[st][mf] = *(const bf16x8*)(ap + (size_t)(16 * mf) * K + 32 * st);
        }
        f32x4 acc[NF][MFR];
#pragma unroll
        for (int nf = 0; nf < NF; ++nf)
#pragma unroll
            for (int mf = 0; mf < MFR; ++mf) acc[nf][mf] = (f32x4){0.f, 0.f, 0.f, 0.f};
#pragma unroll
        for (int st = 0; st < NSTEP; ++st)
#pragma unroll
            for (int nf = 0; nf < NF; ++nf)
#pragma unroll
                for (int mf = 0; mf < MFR; ++mf) acc[nf][mf] = __builtin_amdgcn_mfma_f32_16x16x32_bf16(bfr[st][nf], afr[st][mf], acc[nf][mf], 0, 0, 0);
#pragma unroll
        for (int nf = 0; nf < NF; ++nf)
#pragma unroll
            for (int mf = 0; mf < MFR; ++mf) red[((wave * NF + nf) * MFR + mf) * 64 + lane] = acc[nf][mf];
        __syncthreads();
        if (wave < MFR) {
            if constexpr (Epi::KHALVES) {
                f32x4 x[2];
#pragma unroll
                for (int hf = 0; hf < 2; ++hf) {
                    f32x4 t = red[((4 * hf) * MFR + wave) * 64 + lane];
#pragma unroll
                    for (int w = 1; w < 4; ++w) t = t + red[((4 * hf + w) * MFR + wave) * 64 + lane];
                    x[hf] = t;
                }
                E.skinny(x, r0 + 16 * wave + fr, ncol, fq);
            } else {
                f32x4 x[NF];
#pragma unroll
                for (int nf = 0; nf < NF; ++nf) {
                    f32x4 t = red[((0 * NF + nf) * MFR + wave) * 64 + lane];
#pragma unroll
                    for (int w = 1; w < 8; ++w) t = t + red[((w * NF + nf) * MFR + wave) * 64 + lane];
                    x[nf] = t;
                }
                E.skinny(x, r0 + 16 * wave + fr, ncol, fq);
            }
        }
        __syncthreads();
    }
}

__device__ __forceinline__ void attn_prompt_item(const Params& p, unsigned char* lds, int item, int tid, bf16* obuf) {
    unsigned char* ws = p.ws;
    const int kvh = item & 1, n = (item >> 1) & 31, b = item >> 6;
    bf16* Ks = (bf16*)lds;
    bf16* VT = (bf16*)(lds + 36864);
    const bf16* kbuf = (const bf16*)(ws + WS_K); const bf16* vbuf = (const bf16*)(ws + WS_V); bf16* qbuf = (bf16*)(ws + WS_Q);
#pragma unroll
    for (int i = 0; i < 4; ++i) {
        const int c = tid + NTHREADS * i, r = c >> 3, ch = c & 7; const int trow = (n - 1) * 128 + r;
        u32x4 kk = (u32x4){0u, 0u, 0u, 0u}, vv = kk;
        if (trow >= 0) { const size_t go = (size_t)(b * TPR + trow) * 128 + kvh * 64 + ch * 8; kk = *(const u32x4*)(kbuf + go); vv = *(const u32x4*)(vbuf + go); }
        *(u32x4*)(Ks + r * 72 + ch * 8) = kk;
        if (n == 31 && r >= 128) {
            float* ko = p.out + O_KWP + ((size_t)(b * 128 + (r - 128)) * 2 + kvh) * 64 + ch * 8; float* vo = p.out + O_VWP + ((size_t)(b * 128 + (r - 128)) * 2 + kvh) * 64 + ch * 8;
            *(f32x4*)ko = (f32x4){bflo(kk.x), bfhi(kk.x), bflo(kk.y), bfhi(kk.y)}; *(f32x4*)(ko + 4) = (f32x4){bflo(kk.z), bfhi(kk.z), bflo(kk.w), bfhi(kk.w)};
            *(f32x4*)vo = (f32x4){bflo(vv.x), bfhi(vv.x), bflo(vv.y), bfhi(vv.y)}; *(f32x4*)(vo + 4) = (f32x4){bflo(vv.z), bfhi(vv.z), bflo(vv.w), bfhi(vv.w)};
        }
        bf16* vd = VT + (ch * 8) * 264 + r;
        vd[0 * 264] = (bf16)(vv.x & 0xffffu); vd[1 * 264] = (bf16)(vv.x >> 16); vd[2 * 264] = (bf16)(vv.y & 0xffffu); vd[3 * 264] = (bf16)(vv.y >> 16);
        vd[4 * 264] = (bf16)(vv.z & 0xffffu); vd[5 * 264] = (bf16)(vv.z >> 16); vd[6 * 264] = (bf16)(vv.w & 0xffffu); vd[7 * 264] = (bf16)(vv.w >> 16);
    }
    __syncthreads();
    const int wave = tid >> 6, lane = tid & 63, fr = lane & 15, fq = lane >> 4;
    const int i0 = 16 * wave, kb = i0 < 96 ? i0 : 96;
    const int qi = i0 + fr;
    const size_t qrow = (size_t)(b * TPR + n * 128 + qi);
    const int jlo = (n == 0) ? (qi + 1 > 128 ? qi + 1 : 128) : qi + 1; const int jbase = kb + 4 * fq - jlo; const unsigned jlim = (unsigned)(qi + 128 - jlo);
    bf16x8 qn0 = *(const bf16x8*)(qbuf + qrow * 512 + kvh * 256 + 8 * fq), qn1 = *(const bf16x8*)(qbuf + qrow * 512 + kvh * 256 + 8 * fq + 32);
#pragma unroll 1
    for (int hh = 0; hh < 4; ++hh) {
        const int h = kvh * 4 + hh;
        const float sink = p.in[I_SINK][h];
        bf16* qp = qbuf + qrow * 512 + h * 64;
        const bf16x8 q0 = qn0, q1 = qn1;
        asm volatile("" ::: "memory");
        { const bf16* qnx = qbuf + qrow * 512 + (kvh * 4 + (hh < 3 ? hh + 1 : 3)) * 64; qn0 = *(const bf16x8*)(qnx + 8 * fq); qn1 = *(const bf16x8*)(qnx + 8 * fq + 32); }
        f32x4 s[10];
        __builtin_amdgcn_s_setprio(1);
#pragma unroll
        for (int f = 0; f < 10; ++f) {
            const bf16* kp = Ks + (kb + 16 * f + fr) * 72 + 8 * fq;
            f32x4 a = (f32x4){0.f, 0.f, 0.f, 0.f};
            a = __builtin_amdgcn_mfma_f32_16x16x32_bf16(*(const bf16x8*)kp, q0, a, 0, 0, 0);
            a = __builtin_amdgcn_mfma_f32_16x16x32_bf16(*(const bf16x8*)(kp + 32), q1, a, 0, 0, 0);
            s[f] = a;
        }
        __builtin_amdgcn_s_setprio(0);
        float mx = sink;
#pragma unroll
        for (int f = 0; f < 10; ++f)
#pragma unroll
            for (int r = 0; r < 4; ++r) { const bool ok = (unsigned)(jbase + 16 * f + r) <= jlim;
                s[f][r] = ok ? s[f][r] : -__builtin_inff(); mx = fmaxf(mx, s[f][r]); }
        mx = fmaxf(mx, __shfl_xor(mx, 16)); mx = fmaxf(mx, __shfl_xor(mx, 32));
        float sum = 0.f;
#pragma unroll
        for (int f = 0; f < 10; ++f)
#pragma unroll
            for (int r = 0; r < 4; ++r) { const float e = __expf(s[f][r] - mx); s[f][r] = e; sum += e; }
        sum += __shfl_xor(sum, 16); sum += __shfl_xor(sum, 32);
        sum += __expf(sink - mx);
        const float inv = 1.f / sum;
        bf16x8 pb[5];
#pragma unroll
        for (int m = 0; m < 5; ++m) { u32x4 w; w.x = pk2(s[2 * m][0], s[2 * m][1]); w.y = pk2(s[2 * m][2], s[2 * m][3]); w.z = pk2(s[2 * m + 1][0], s[2 * m + 1][1]); w.w = pk2(s[2 * m + 1][2], s[2 * m + 1][3]);
            pb[m] = __builtin_bit_cast(bf16x8, w); }
        __builtin_amdgcn_s_setprio(1);
#pragma unroll
        for (int df = 0; df < 4; ++df) {
            f32x4 o = (f32x4){0.f, 0.f, 0.f, 0.f};
            const bf16* vp = VT + (16 * df + fr) * 264 + kb + 4 * fq;
#pragma unroll
            for (int m = 0; m < 5; ++m) {
                const u32x2 lo = *(const u32x2*)(vp + 32 * m), hi = *(const u32x2*)(vp + 32 * m + 16);
                const u32x4 w = (u32x4){lo.x, lo.y, hi.x, hi.y};
                o = __builtin_amdgcn_mfma_f32_16x16x32_bf16(__builtin_bit_cast(bf16x8, w), pb[m], o, 0, 0, 0);
            }
            st_bf4(obuf + qrow * 1024 + h * 64 + 16 * df + 4 * fq, o * inv);
        }
        __builtin_amdgcn_s_setprio(0);
    }
    __syncthreads();
}

__device__ __forceinline__ void attn_sample_block(const Params& p, unsigned char* lds, int item, int tid) {
    unsigned char* ws = p.ws;
    const int kvh = item & 1, db = item >> 1, lane = tid & 63, wave = tid >> 6;
    float* qs = (float*)lds;
    float* sc = (float*)(lds + 1024);
    float* red = (float*)(lds + 3072);
    bf16* qbuf = (bf16*)(ws + WS_Q);
    const size_t row = (size_t)(MPROMPT + db);
    if (tid < 256) qs[tid] = bf2f(qbuf[row * 512 + kvh * 256 + tid]);
    const int key = tid >> 2, part = tid & 3;
    f32x4 kv[4];
    {
        float* dst = p.out + O_KWS + ((size_t)(db * 128 + key) * 2 + kvh) * 64 + part * 16;
        if (key < 127) {
            const float* src = p.in[I_SK] + ((size_t)(db * 128 + key + 1) * 2 + kvh) * 64 + part * 16;
#pragma unroll
            for (int c = 0; c < 4; ++c) kv[c] = *(const f32x4*)(src + 4 * c);
        } else {
            const bf16* src = (const bf16*)(ws + WS_K) + row * 128 + kvh * 64 + part * 16;
#pragma unroll
            for (int c = 0; c < 4; ++c) kv[c] = ld_bf4(src + 4 * c);
        }
#pragma unroll
        for (int c = 0; c < 4; ++c) *(f32x4*)(dst + 4 * c) = kv[c];
    }
    __syncthreads();
    {
        float a[4];
#pragma unroll
        for (int hh = 0; hh < 4; ++hh) {
            float t = 0.f;
#pragma unroll
            for (int c = 0; c < 4; ++c) { const f32x4 w = *(const f32x4*)(qs + hh * 64 + part * 16 + 4 * c); t += kv[c][0] * w[0] + kv[c][1] * w[1] + kv[c][2] * w[2] + kv[c][3] * w[3]; }
            t += __shfl_xor(t, 1); t += __shfl_xor(t, 2); a[hh] = t;
        }
        if (part == 0) { sc[key] = a[0]; sc[128 + key] = a[1]; sc[256 + key] = a[2]; sc[384 + key] = a[3]; }
    }
    __syncthreads();
    if (wave < 4) {
        const float sink = p.in[I_SINK][kvh * 4 + wave];
        const float s0 = sc[wave * 128 + lane], s1 = sc[wave * 128 + 64 + lane];
        const float mx = fmaxf(wave_max(fmaxf(s0, s1)), sink);
        const float e0 = __expf(s0 - mx), e1 = __expf(s1 - mx);
        const float inv = 1.f / (wave_sum(e0 + e1) + __expf(sink - mx));
        sc[wave * 128 + lane] = e0 * inv; sc[wave * 128 + 64 + lane] = e1 * inv;
    }
    __syncthreads();
    {
        const int chunk = tid & 15, kg = tid >> 4;
        f32x4 vv[4];
#pragma unroll
        for (int i = 0; i < 4; ++i) {
            const int k2 = kg * 4 + i;
            if (k2 < 127) vv[i] = *(const f32x4*)(p.in[I_SV] + ((size_t)(db * 128 + k2 + 1) * 2 + kvh) * 64 + chunk * 4);
            else vv[i] = ld_bf4((const bf16*)(ws + WS_V) + row * 128 + kvh * 64 + chunk * 4);
            *(f32x4*)(p.out + O_VWS + ((size_t)(db * 128 + k2) * 2 + kvh) * 64 + chunk * 4) = vv[i];
        }
        f32x4 o[4];
#pragma unroll
        for (int hh = 0; hh < 4; ++hh) {
            f32x4 t = (f32x4){0.f, 0.f, 0.f, 0.f};
#pragma unroll
            for (int i = 0; i < 4; ++i) t = t + vv[i] * sc[hh * 128 + kg * 4 + i];
#pragma unroll
            for (int e = 0; e < 4; ++e) { t[e] += __shfl_xor(t[e], 16); t[e] += __shfl_xor(t[e], 32); }
            o[hh] = t;
        }
        if (lane < 16) {
#pragma unroll
            for (int hh = 0; hh < 4; ++hh) *(f32x4*)(red + (wave * 4 + hh) * 64 + chunk * 4) = o[hh];
        }
    }
    __syncthreads();
    if (tid < 256) {
        float t = 0.f;
#pragma unroll
        for (int w = 0; w < 8; ++w) t += red[w * 256 + tid];
        ((bf16*)(ws + WS_AS))[row * 1024 + kvh * 256 + tid] = (bf16)f2bf(t);
    }
    __syncthreads();
}

template <bool PB> __device__ __forceinline__ void ssm_item(const Params& p, unsigned char* ldsw, int item, int lane) {
    unsigned char* ws = p.ws;
    const int seg = item & 15, g = (item >> 4) & 31, b = item >> 9;
    const int fr = lane & 15, fq = lane >> 4;
    float* BuT = (float*)ldsw;
    bf16* hc = (bf16*)(ldsw + 10240);
    const f32x2 lb = ((const f32x2*)(ws + WS_LBAR))[g * 64 + lane];
    const bf16* bbm = (const bf16*)(ws + WS_BBM); const bf16* ccm = (const bf16*)(ws + WS_CCM);
    bf16x4 bb[8];
#pragma unroll
    for (int f = 0; f < 8; ++f) bb[f] = *(const bf16x4*)(bbm + ((size_t)(g * 128 + 16 * f + fr) * 16 + 4 * fq));
    bf16x8 cc[4]; f32x4 dv = (f32x4){0.f, 0.f, 0.f, 0.f};
    if (PB) {
#pragma unroll
        for (int s = 0; s < 4; ++s) cc[s] = *(const bf16x8*)(ccm + ((size_t)(g * 16 + fr) * 128 + 8 * fq + 32 * s));
        dv = *(const f32x4*)(p.in[I_SD] + g * 16 + 4 * fq);
    }
    float hr = 0.f, hi = 0.f;
    f32x2* E = (f32x2*)(ws + WS_E);
    if (PB) {
        const f32x2 ls = ((const f32x2*)(ws + WS_LBARS))[g * 64 + lane];
        f32x2 ev[15];
#pragma unroll
        for (int j = 0; j < 15; ++j) ev[j] = E[((size_t)((b * 32 + g) * 16 + (j < seg ? j : 0))) * 64 + lane];
#pragma unroll
        for (int j = 0; j < 15; ++j) { const float nr = ls.x * hr - ls.y * hi + ev[j].x, ni = ls.x * hi + ls.y * hr + ev[j].y; hr = (j < seg) ? nr : hr; hi = (j < seg) ? ni : hi; }
    }
    const size_t row0 = (size_t)b * TPR + seg * 256;
    const bf16* up = (const bf16*)(ws + WS_U) + (row0 + fr) * 512 + g * 16 + 4 * fq;
    bf16* zb = (bf16*)(ws + WS_Z);
    u32x2 uw_n = *(const u32x2*)up;
    for (int ch = 0; ch < 16; ++ch) {
        const u32x2 uw = uw_n;
        uw_n = *(const u32x2*)(up + (size_t)(ch < 15 ? ch + 1 : 15) * 16 * 512);
        const bf16x4 ua = __builtin_bit_cast(bf16x4, uw);
#pragma unroll
        for (int f = 0; f < 8; ++f) {
            f32x4 a = (f32x4){0.f, 0.f, 0.f, 0.f};
            a = __builtin_amdgcn_mfma_f32_16x16x16bf16_1k(ua, bb[f], a, 0, 0, 0);
            *(f32x4*)(BuT + (16 * f + fr) * 20 + 4 * fq) = a;
        }
        LDS_WAIT();
#pragma unroll
        for (int j = 0; j < 4; ++j) {
            const f32x4 r4 = *(const f32x4*)(BuT + lane * 20 + 4 * j), i4 = *(const f32x4*)(BuT + (64 + lane) * 20 + 4 * j);
#pragma unroll
            for (int e = 0; e < 4; ++e) {
                const float nr = lb.x * hr - lb.y * hi + r4[e], ni = lb.x * hi + lb.y * hr + i4[e]; hr = nr; hi = ni;
                if (PB) *(unsigned*)(hc + (4 * j + e) * 136 + 2 * lane) = pk2(hr, hi);
            }
        }
        if (PB) {
            LDS_WAIT();
            f32x4 y = (f32x4){0.f, 0.f, 0.f, 0.f};
#pragma unroll
            for (int s = 0; s < 4; ++s) y = __builtin_amdgcn_mfma_f32_16x16x32_bf16(cc[s], *(const bf16x8*)(hc + fr * 136 + 8 * fq + 32 * s), y, 0, 0, 0);
            const f32x4 uf = (f32x4){bflo(uw.x), bfhi(uw.x), bflo(uw.y), bfhi(uw.y)};
            y = y + dv * uf;
            st_bf4(zb + (row0 + ch * 16 + fr) * 512 + g * 16 + 4 * fq, (f32x4){gelu_tanh(y[0]), gelu_tanh(y[1]), gelu_tanh(y[2]), gelu_tanh(y[3])});
        }
        LDS_WAIT();
    }
    if (!PB) E[((size_t)((b * 32 + g) * 16 + seg)) * 64 + lane] = (f32x2){hr, hi};
    else if (seg == NSEG - 1) { p.out[O_SRP + (size_t)(b * 32 + g) * 64 + lane] = hr; p.out[O_SIP + (size_t)(b * 32 + g) * 64 + lane] = hi; }
}

template <int NI> __device__ __forceinline__ void ssm_sample_items(const Params& p, unsigned char* ldsw, int item0, int istep, int lane) {
    unsigned char* ws = p.ws;
    float* hs = (float*)ldsw;
    const int ho = lane & 15, part = lane >> 4;
    u32x4 u0[NI], u1[NI]; f32x4 bw[NI][8]; f32x2 lb[NI]; float h0r[NI], h0i[NI], dsk[NI]; f32x4 crr[NI][4], cii[NI][4];
#pragma unroll
    for (int k = 0; k < NI; ++k) {
        const int item = item0 + k * istep, g = item & 31, db = item >> 5;
        const bf16* up = (const bf16*)(ws + WS_U) + (size_t)(MPROMPT + db) * 512 + g * 16;
        u0[k] = *(const u32x4*)up; u1[k] = *(const u32x4*)(up + 8);
        const f32x4* bbf = (const f32x4*)((const f32x2*)(ws + WS_BBF) + (size_t)(g * 64 + lane) * 16);
#pragma unroll
        for (int h = 0; h < 8; ++h) bw[k][h] = bbf[h];
        lb[k] = ((const f32x2*)(ws + WS_LBAR))[g * 64 + lane];
        h0r[k] = p.in[I_SRE][(size_t)(db * 32 + g) * 64 + lane]; h0i[k] = p.in[I_SIM][(size_t)(db * 32 + g) * 64 + lane];
        const f32x4* cr = (const f32x4*)(p.in[I_CRE] + (size_t)(g * 16 + ho) * 64 + part * 16); const f32x4* ci = (const f32x4*)(p.in[I_CIM] + (size_t)(g * 16 + ho) * 64 + part * 16);
#pragma unroll
        for (int q = 0; q < 4; ++q) { crr[k][q] = cr[q]; cii[k][q] = ci[q]; }
        dsk[k] = p.in[I_SD][g * 16 + ho];
    }
    float uo[NI];
#pragma unroll
    for (int k = 0; k < NI; ++k) {
        const int item = item0 + k * istep, g = item & 31, db = item >> 5;
        const float uf[16] = {bflo(u0[k].x), bfhi(u0[k].x), bflo(u0[k].y), bfhi(u0[k].y), bflo(u0[k].z), bfhi(u0[k].z), bflo(u0[k].w), bfhi(u0[k].w),
                              bflo(u1[k].x), bfhi(u1[k].x), bflo(u1[k].y), bfhi(u1[k].y), bflo(u1[k].z), bfhi(u1[k].z), bflo(u1[k].w), bfhi(u1[k].w)};
        float br = 0.f, bi = 0.f;
#pragma unroll
        for (int h = 0; h < 8; ++h) { const f32x4 w = bw[k][h]; br += w[0] * uf[2 * h] + w[2] * uf[2 * h + 1]; bi += w[1] * uf[2 * h] + w[3] * uf[2 * h + 1]; }
        const float hr = lb[k].x * h0r[k] - lb[k].y * h0i[k] + br, hi = lb[k].x * h0i[k] + lb[k].y * h0r[k] + bi;
        p.out[O_SRS + (size_t)(db * 32 + g) * 64 + lane] = hr; p.out[O_SIS + (size_t)(db * 32 + g) * 64 + lane] = hi;
        hs[k * 128 + lane] = hr; hs[k * 128 + 64 + lane] = hi;
        float t = uf[0];
#pragma unroll
        for (int q = 1; q < 16; ++q) t = (ho == q) ? uf[q] : t;
        uo[k] = t;
    }
    LDS_WAIT();
#pragma unroll
    for (int k = 0; k < NI; ++k) {
        const int item = item0 + k * istep, g = item & 31, db = item >> 5;
        const f32x4* hr4 = (const f32x4*)(hs + k * 128 + part * 16); const f32x4* hi4 = (const f32x4*)(hs + k * 128 + 64 + part * 16);
        const f32x4 t = crr[k][0] * hr4[0] + crr[k][1] * hr4[1] + crr[k][2] * hr4[2] + crr[k][3] * hr4[3] - cii[k][0] * hi4[0] - cii[k][1] * hi4[1] - cii[k][2] * hi4[2] - cii[k][3] * hi4[3];
        float y = (t[0] + t[1]) + (t[2] + t[3]);
        y += __shfl_xor(y, 16); y += __shfl_xor(y, 32);
        y += dsk[k] * uo[k];
        if (part == 0) ((bf16*)(ws + WS_Z))[(size_t)(MPROMPT + db) * 512 + g * 16 + ho] = (bf16)f2bf(gelu_tanh(y));
    }
    LDS_WAIT();
}

#define XB_TMO      128
#define XB_XCNT(j)  (256  + 64 * (j))
#define XB_XSUB(j)  (1280 + 64 * (j))
#define XB_XGEN(j)  (2304 + 64 * (j))
#define XB_TOP      3328
#define XB_TOPGEN   3392
#define XCD_BAR_WORDS 3456
#define XB_SPIN_CAP (1u << 18)

__device__ __forceinline__ unsigned xb_ld(unsigned* p)              { return __hip_atomic_load(p, __ATOMIC_RELAXED, __HIP_MEMORY_SCOPE_AGENT); }
__device__ __forceinline__ unsigned xb_add(unsigned* p, unsigned v) { return __hip_atomic_fetch_add(p, v, __ATOMIC_RELAXED, __HIP_MEMORY_SCOPE_AGENT); }
__device__ __forceinline__ unsigned xb_xcc_id() { return (unsigned)__builtin_amdgcn_s_getreg((3 << 11) | 20) & 0xFu; }
#define XB_SPIN(cond, bar) do { unsigned _sp = 0; while (cond) { __builtin_amdgcn_s_sleep(1); \
    if ((++_sp & 255u) == 0u) { if (xb_ld(&(bar)[XB_TMO])) break; if (_sp > XB_SPIN_CAP) { atomicAdd(&(bar)[XB_TMO], 1u); break; } } } } while (0)

struct XcdBarrier {
    unsigned* bar; unsigned x;
    volatile LAS unsigned* st;
};

__device__ __forceinline__ XcdBarrier xcd_barrier_post(unsigned* bar, volatile LAS unsigned* st) {
    XcdBarrier b; b.bar = bar; b.x = xb_xcc_id(); b.st = st;
    if (threadIdx.x == 0) (void)xb_add(&bar[XB_XCNT(b.x)], 1u);
    return b;
}
__device__ __forceinline__ void xcd_barrier_complete(unsigned* bar, unsigned x, unsigned& nloc, unsigned& nx) {
    const unsigned G = gridDim.x * gridDim.y * gridDim.z;
    unsigned sum, cnt, mine, sp = 0u;
    for (;;) {
        sum = 0u; cnt = 0u; mine = 0u;
#pragma unroll
        for (unsigned j = 0; j < 16; ++j) { const unsigned c = xb_ld(&bar[XB_XCNT(j)]); sum += c; cnt += (c > 0u) ? 1u : 0u; mine = (j == x) ? c : mine; }
        if (sum == G) break;
        __builtin_amdgcn_s_sleep(1);
        if ((++sp & 255u) == 0u) { if (xb_ld(&bar[XB_TMO])) break; if (sp > XB_SPIN_CAP) { atomicAdd(&bar[XB_TMO], 1u); break; } }
    }
    nloc = mine > 0u ? mine : 1u; nx = cnt > 0u ? cnt : 1u;
}

__device__ __forceinline__ void xcd_barrier(const XcdBarrier& b, const bool is_t0) {
    asm volatile("s_waitcnt vmcnt(0)" ::: "memory");
    __syncthreads();
    if (is_t0) {
        unsigned* bar = b.bar;
        __builtin_amdgcn_s_waitcnt(0);
        unsigned nloc = b.st[0], nx = b.st[1];
        if (nloc == 0u) { xcd_barrier_complete(bar, b.x, nloc, nx); b.st[0] = nloc; b.st[1] = nx; }
        const unsigned old = xb_add(&bar[XB_XSUB(b.x)], 1u);
        const unsigned gen = old / nloc;
        if (old + 1u == (gen + 1u) * nloc) {
            __builtin_amdgcn_fence(__ATOMIC_RELEASE, "agent");
            asm volatile("s_waitcnt vmcnt(0)" ::: "memory");
            const unsigned og = xb_add(&bar[XB_TOP], 1u);
            const unsigned tg = og / nx;
            if (og + 1u == (tg + 1u) * nx) xb_add(&bar[XB_TOPGEN], 1u);
            else XB_SPIN(xb_ld(&bar[XB_TOPGEN]) == tg, bar);
            __builtin_amdgcn_fence(__ATOMIC_ACQUIRE, "agent");
            xb_add(&bar[XB_XGEN(b.x)], 1u);
            asm volatile("s_waitcnt vmcnt(0)" ::: "memory");
        } else {
            XB_SPIN(xb_ld(&bar[XB_XGEN(b.x)]) == gen, bar);
            __builtin_amdgcn_fence(__ATOMIC_ACQUIRE, "agent");
            asm volatile("s_waitcnt vmcnt(0)" ::: "memory");
        }
    }
    __syncthreads();
}

#ifndef XPROBE
#define XPROBE 0
#endif
#ifndef DUP
#define DUP 0
#endif
#ifndef P2S
#define P2S 15
#endif
#ifndef PH
#define PH 0x3ff
#endif
__global__ void __launch_bounds__(NTHREADS, 2) mk_fwd(Params p) {
    extern __shared__ __attribute__((aligned(16))) unsigned char lds[];
    cg::grid_group grid = cg::this_grid();
    const int wave = __builtin_amdgcn_readfirstlane(threadIdx.x >> 6);
    const int G = gridDim.x, bx = blockIdx.x;
    const int gw = bx * NWAVES + wave, NGW = G * NWAVES;
    unsigned char* ws = p.ws;
    PG8_LAS unsigned char* ldsg = (PG8_LAS unsigned char*)lds;
    if (gridDim.x == 0x7fffffffu) grid.sync();
    if (threadIdx.x < 4) ((volatile LAS unsigned*)(ldsg + 131072 + 64))[threadIdx.x] = 0u;
    __syncthreads();
    (void)xcd_barrier_post((unsigned*)(ws + WS_BAR), (volatile LAS unsigned*)(ldsg + 131072 + 64));
#define GRID_BAR() do { XcdBarrier b_; b_.bar = (unsigned*)(p.ws + WS_BAR); b_.x = xb_xcc_id(); b_.st = (volatile LAS unsigned*)(ldsg + 131072 + 64); xcd_barrier(b_, wave == 0 && fresh_lane() == 0); } while (0)

#if PH & (1<<0)
    for (int rep_ = 0; rep_ < 1 + ((DUP >> 0) & 1); ++rep_) {
    { int lane_ = fresh_lane();
    p0_weights(p, lds, 0, P0_I0 + 8 * 16, gw, NGW, wave, lane_);
    p0_prologue(p, lds, gw, NGW, wave, lane_); }
    GRID_BAR();

    }
#endif
#if PH & (1<<1)
    for (int rep_ = 0; rep_ < 1 + ((DUP >> 1) & 1); ++rep_) {
    {
        pg8::Gemm g{(const bf16*)(ws + WS_XB), (const bf16*)(ws + WS_WIN), MPROMPT, 3072, D}; pg8::StaticOrder S; S.init(MPROMPT, 3072, G, bx);
        EpiIn E{ws, p.in[I_BG], 0};
        { int lane_ = fresh_lane(); skinny_gemm<EpiIn, 1024, 1>(lds, g.A, g.Bt, 3072, E, bx, G, wave, lane_, 0); }
        pg8::gemm_phase<EpiIn, pg8::StaticOrder, true, true>(ldsg, g, S, E, wave, wave * 64 + fresh_lane());
    }
    GRID_BAR();

    }
#endif
#if PH & (1<<2)
    for (int rep_ = 0; rep_ < 1 + ((DUP >> 2) & 1); ++rep_) {
#if P2S & 1
#if XPROBE & 1
    for (int it = bx; it < 256; it += G) { int tid_ = wave * 64 + fresh_lane(); attn_prompt_item(p, lds, it, tid_, (bf16*)(ws + WS_M)); }
#endif
    for (int it = bx; it < 256; it += G) { int tid_ = wave * 64 + fresh_lane(); attn_prompt_item(p, lds, it, tid_, (bf16*)(ws + WS_AS)); }
    }
#endif
#if P2S & 2
    for (int it = bx; it < 256; it += G) { int tid_ = wave * 64 + fresh_lane(); attn_sample_block(p, lds, it, tid_); }
#endif
#if XPROBE & 2
    for (int it = gw; it < 2048; it += NGW) { int lane_ = fresh_lane(); ssm_item<false>(p, lds + wave * 16384, it, lane_); }
    { int it = gw; for (; it + NGW < 4096; it += 2 * NGW) { int lane_ = fresh_lane(); ssm_sample_items<2>(p, lds + wave * 16384, it, NGW, lane_); }
      if (it < 4096) { int lane_ = fresh_lane(); ssm_sample_items<1>(p, lds + wave * 16384, it, NGW, lane_); } }
#endif
#if P2S & 4
    for (int it = gw; it < 2048; it += NGW) { int lane_ = fresh_lane(); ssm_item<false>(p, lds + wave * 16384, it, lane_); }
#endif
#if P2S & 8
    { int it = gw; for (; it + NGW < 4096; it += 2 * NGW) { int lane_ = fresh_lane(); ssm_sample_items<2>(p, lds + wave * 16384, it, NGW, lane_); }
      if (it < 4096) { int lane_ = fresh_lane(); ssm_sample_items<1>(p, lds + wave * 16384, it, NGW, lane_); } }
#endif
    GRID_BAR();

#endif
#if PH & (1<<3)
    for (int rep_ = 0; rep_ < 1 + ((DUP >> 3) & 1); ++rep_) {
    for (int it = gw; it < 2048; it += NGW) { int lane_ = fresh_lane(); ssm_item<true>(p, lds + wave * 16384, it, lane_); }
    GRID_BAR();

    }
#endif
#if PH & (1<<4)
    for (int rep_ = 0; rep_ < 1 + ((DUP >> 4) & 1); ++rep_) {
    {
        const bool g256 = (G == 256);
        pg8::Gemm g{(const bf16*)(ws + WS_Z), (const bf16*)(ws + WS_WGLU), MPROMPT, 512, 512}; pg8::StaticOrder S; S.init(MPROMPT, 512, G, bx);
        EpiGlu E{(const bf16*)(ws + WS_Z), (bf16*)(ws + WS_AS), p.in[I_BGLU]};
        pg8::Gemm g2{(const bf16*)(ws + WS_XB), (const bf16*)(ws + WS_WIN) + (size_t)3072 * D, MPROMPT, 256, D}; pg8::StaticOrder S2;
        if (g256) S2.init(MPROMPT, 256, 64, (bx >= 128 && bx < 192) ? bx - 128 : (1 << 20)); else S2.init(MPROMPT, 256, G, bx);
        EpiIn E2{ws, p.in[I_BG], 24};
        const int lo4 = g256 ? 192 : 0;
        { int lane_ = fresh_lane(); skinny_gemm<EpiGlu, 512, 1>(lds, g.A, g.Bt, 512, E, bx, G, wave, lane_, lo4); }
        { int lane_ = fresh_lane(); skinny_gemm<EpiIn, 1024, 1>(lds, g2.A, g2.Bt, 256, E2, bx, G, wave, lane_, lo4); }
        pg8::gemm_phase<EpiGlu, pg8::StaticOrder, true, true>(ldsg, g, S, E, wave, wave * 64 + fresh_lane());
        pg8::gemm_phase<EpiIn, pg8::StaticOrder, true, true>(ldsg, g2, S2, E2, wave, wave * 64 + fresh_lane());
        {
            constexpr int W0 = P0_I0 + 8 * 16, WSPLIT = W0 + 1792, WDOWN = P0_NITEMS - 44 * 32;
            const int lane_ = fresh_lane();
            if (!g256) p0_weights(p, lds, W0, P0_NITEMS, gw, NGW, wave, lane_);
            else if (bx < 128) p0_weights(p, lds, W0, WSPLIT, bx * NWAVES + wave, 128 * NWAVES, wave, lane_);
            else if (bx >= 192) p0_weights(p, lds, WSPLIT, WDOWN, (bx - 192) * NWAVES + wave, 64 * NWAVES, wave, lane_);
        }
    }
    GRID_BAR();

    }
#endif
#if PH & (1<<5)
    for (int rep_ = 0; rep_ < 1 + ((DUP >> 5) & 1); ++rep_) {
    {
        pg8::Gemm g{(const bf16*)(ws + WS_AS), (const bf16*)(ws + WS_WBA), MPROMPT, D, D}; pg8::StaticOrder S; S.init(MPROMPT, D, G, bx);
        EpiMerge E{(const bf16*)(ws + WS_G), (bf16*)(ws + WS_M)};
        { int lane_ = fresh_lane(); skinny_gemm<EpiMerge, 1024, 4>(lds, g.A, g.Bt, D, E, bx, G, wave, lane_, 0); }
        pg8::gemm_phase<EpiMerge, pg8::StaticOrder, true, true>(ldsg, g, S, E, wave, wave * 64 + fresh_lane());
    }
    GRID_BAR();

    }
#endif
#if PH & (1<<6)
    for (int rep_ = 0; rep_ < 1 + ((DUP >> 6) & 1); ++rep_) {
    {
        pg8::Gemm g{(const bf16*)(ws + WS_M), (const bf16*)(ws + WS_WOUT), MPROMPT, D, D}; pg8::StaticOrder S; S.init(MPROMPT, D, G, bx);
        EpiRes<0> E{p.in[I_XP], p.in[I_XS], p.out, (bf16*)(ws + WS_XB), (float*)(ws + WS_SS1)};
#if XPROBE & 8
        { EpiRes<0> E2{p.in[I_XP], p.in[I_XS], (float*)(ws + WS_ACT), (bf16*)(ws + WS_XB), (float*)(ws + WS_E)};
          pg8::gemm_phase<EpiRes<0>, pg8::StaticOrder, true, true>(ldsg, g, S, E2, wave, wave * 64 + fresh_lane()); }
#endif
        { int lane_ = fresh_lane(); skinny_gemm<EpiRes<0>, 1024, 4>(lds, g.A, g.Bt, D, E, bx, G, wave, lane_, 0); }
        pg8::gemm_phase<EpiRes<0>, pg8::StaticOrder, true, true>(ldsg, g, S, E, wave, wave * 64 + fresh_lane());
    }
    GRID_BAR();

    }
#endif
#if PH & (1<<7)
    for (int rep_ = 0; rep_ < 1 + ((DUP >> 7) & 1); ++rep_) {
    {
        pg8::Gemm g{(const bf16*)(ws + WS_XB), (const bf16*)(ws + WS_WGU), MPROMPT, NGU, D}; pg8::StaticOrder S; S.init(MPROMPT, NGU, G, bx);
        EpiFfnUp E{(const float*)(ws + WS_SS1), (bf16*)(ws + WS_ACT)};
        { int lane_ = fresh_lane(); skinny_gemm<EpiFfnUp, 1024, 1>(lds, g.A, g.Bt, NGU, E, bx, G, wave, lane_, (G == 256) ? 128 : 0); }
        pg8::gemm_phase<EpiFfnUp, pg8::StaticOrder, true, true>(ldsg, g, S, E, wave, wave * 64 + fresh_lane());
        if (G == 256 && bx >= 128) { const int lane_ = fresh_lane(); p0_weights(p, lds, P0_NITEMS - 44 * 32, P0_NITEMS, (bx - 128) * NWAVES + wave, 128 * NWAVES, wave, lane_); }
    }
    GRID_BAR();

    }
#endif
#if PH & (1<<8)
    {
        pg8::Gemm g{(const bf16*)(ws + WS_ACT), (const bf16*)(ws + WS_WD), MPROMPT, D, FF}; pg8::StaticOrder S; S.init(MPROMPT, D, G, bx);
        EpiRes<1> E{p.in[I_XP], p.in[I_XS], p.out, (bf16*)(ws + WS_XB), (float*)(ws + WS_SS2)};
        unsigned* cnt = (unsigned*)(ws + WS_CNT);
        const f32x4* g4 = (const f32x4*)p.in[I_NFG]; const float* ss2 = (const float*)(ws + WS_SS2);
        { int lane_ = fresh_lane(); skinny_gemm<EpiRes<1>, 2816, 4>(lds, g.A, g.Bt, D, E, bx, G, wave, lane_, 0); }
        int m0 = 0, m1 = 0, mstep = 2;
        if (G == 256) {
            asm volatile("s_waitcnt vmcnt(0)" ::: "memory"); __syncthreads();
            if (wave == 0 && fresh_lane() == 0) { __builtin_amdgcn_fence(__ATOMIC_RELEASE, "agent"); asm volatile("s_waitcnt vmcnt(0)" ::: "memory");
                __hip_atomic_fetch_add(cnt, 1u, __ATOMIC_RELAXED, __HIP_MEMORY_SCOPE_AGENT); }
            EpiFinal EF{(const bf16*)(ws + WS_XB), p.out, (float*)(ws + WS_SS2), p.in[I_NFG], cnt};
            pg8::gemm_phase<EpiFinal, pg8::StaticOrder, false, true>(ldsg, g, S, EF, wave, wave * 64 + fresh_lane());
            if (bx < 64) {
                if (wave == 0 && fresh_lane() == 0) { unsigned sp = 0; while (__hip_atomic_load(cnt, __ATOMIC_RELAXED, __HIP_MEMORY_SCOPE_AGENT) < (unsigned)G && ++sp < (1u << 22)) __builtin_amdgcn_s_sleep(2);
                    __builtin_amdgcn_fence(__ATOMIC_ACQUIRE, "agent"); asm volatile("s_waitcnt vmcnt(0)" ::: "memory"); }
                __syncthreads();
                if (wave == 0) { m0 = MPROMPT + 2 * bx; m1 = m0 + 2; }
            }
        } else {
            pg8::gemm_phase<EpiRes<1>, pg8::StaticOrder, true, true>(ldsg, g, S, E, wave, wave * 64 + fresh_lane());
            GRID_BAR();
            m0 = 2 * gw; m1 = MR; mstep = 2 * NGW;
        }
        const int lane = fresh_lane();
        for (int mm = m0; mm < m1; mm += mstep) {
            f32x4 v[2][4]; float rs[2];
#pragma unroll
            for (int r = 0; r < 2; ++r) { rs[r] = ss2[mm + r]; const bf16* xr = (const bf16*)(ws + WS_XB) + (size_t)(mm + r) * D + 4 * lane;
#pragma unroll
                for (int j = 0; j < 4; ++j) v[r][j] = ld_bf4(xr + 256 * j); }
#pragma unroll
            for (int r = 0; r < 2; ++r) { const float rstd = 1.f / sqrtf(rs[r] * (1.f / D) + EPS); f32x4* yr = (f32x4*)(p.out + (size_t)(mm + r) * D) + lane;
#pragma unroll
                for (int j = 0; j < 4; ++j) yr[64 * j] = v[r][j] * rstd * g4[lane + 64 * j]; }
        }
    }
#endif
}

#undef GRID_BAR
extern "C" void kernel_launch(void* const* d_in, const int* in_sizes, int n_in, void* d_out, int out_size, void* d_ws, size_t ws_size, hipStream_t stream) {
    static int grid = 0;
    if (grid == 0) {
        if (n_in != 28 || ws_size < WS_END) { fprintf(stderr, "kernel_launch: unexpected n_in %d / ws_size %zu\n", n_in, ws_size); grid = -1; return; }
        int dev = 0, cus = 0, per_cu = 0;
        hipGetDevice(&dev); hipDeviceGetAttribute(&cus, hipDeviceAttributeMultiprocessorCount, dev);
        if (hipFuncSetAttribute((const void*)mk_fwd, hipFuncAttributeMaxDynamicSharedMemorySize, LDS_BYTES) != hipSuccess) { fprintf(stderr, "kernel_launch: hipFuncSetAttribute failed\n"); grid = -1; return; }
        if (hipOccupancyMaxActiveBlocksPerMultiprocessor(&per_cu, (const void*)mk_fwd, NTHREADS, LDS_BYTES) != hipSuccess || per_cu < 1) { fprintf(stderr, "kernel_launch: occupancy query says %d\n", per_cu); per_cu = 1; }
        (void)hipGetLastError();
        grid = cus * 1;
        fprintf(stderr, "kernel_launch: cus %d per_cu %d grid %d\n", cus, per_cu, grid);
    }
    if (grid < 0) return;
    if (hipMemsetAsync(d_ws, 0, WS_ZERO_BYTES, stream) != hipSuccess) { fprintf(stderr, "kernel_launch: memset failed\n"); return; }
    Params prm{};
    for (int i = 0; i < 28; ++i) prm.in[i] = (const float*)d_in[i];
    prm.out = (float*)d_out; prm.ws = (unsigned char*)d_ws;
    void* args[] = {&prm};
    hipError_t e = hipLaunchCooperativeKernel((const void*)mk_fwd, dim3(grid), dim3(NTHREADS), args, LDS_BYTES, stream);
    if (e != hipSuccess) fprintf(stderr, "cooperative launch failed: %s (grid %d)\n", hipGetErrorString(e), grid);
}
```
